# Optimizing an MI355X kernel written in HIP

```python
import math
import jax, jax.numpy as jnp
from jax import lax
import numpy as np

D_MODEL = 1024
BATCH = 2
SEQ = 8192
DEPTH = 1

CHUNK = 64
Q_BLOCK = 128
MEM_LEN = 256

N_DIFF_HEADS = 4
DIFF_DK = 64
DIFF_DV = 128
DIFF_WIDTH = N_DIFF_HEADS * DIFF_DV

POOL_WINDOWS = (2, 4, 8, 16)
POOL_GROUPS = len(POOL_WINDOWS)
POOL_DIM = 128
POOL_WIDTH = POOL_GROUPS * POOL_DIM

MIX_WIDTH = DIFF_WIDTH + POOL_WIDTH
IN_WIDTH = 3 * DIFF_WIDTH + POOL_WIDTH

REL_BUCKETS = 32
REL_MAX_DISTANCE = 128

N_CROSS_HEADS = 4
CROSS_HEAD_DIM = D_MODEL // N_CROSS_HEADS

N_EXPERT_GROUPS = 4
EXPERTS_PER_GROUP = 4
N_EXPERTS = N_EXPERT_GROUPS * EXPERTS_PER_GROUP
TOP_K_INNER = 2
EXPERT_FF = D_MODEL // 4

EPS = 1e-6

kernel_name = "hybrid_diffattn_pool_hiermoe_block"


def rmsnorm(x, g):
    xf = x.astype(jnp.float32)
    y = xf * lax.rsqrt(jnp.mean(xf * xf, axis=-1, keepdims=True) + EPS)
    return (y * g.astype(jnp.float32)).astype(x.dtype)


def rel_bucket(rel):
    nb = REL_BUCKETS // 2
    max_exact = nb // 2
    ret = (rel > 0).astype(jnp.int32) * nb
    n = jnp.abs(rel)
    nf = jnp.maximum(n, 1).astype(jnp.float32)
    large = max_exact + (jnp.log(nf / max_exact) / math.log(REL_MAX_DISTANCE / max_exact)
                         * (nb - max_exact)).astype(jnp.int32)
    large = jnp.minimum(large, nb - 1)
    return ret + jnp.where(n < max_exact, n, large)


def diff_attention(q, k, v, lam, rel_bias):
    B, S = q.shape[0], q.shape[1]
    nb = S // Q_BLOCK
    scale = DIFF_DK ** -0.5
    qb_all = q.reshape(B, nb, Q_BLOCK, N_DIFF_HEADS, 2, DIFF_DK).transpose(1, 0, 3, 4, 2, 5)
    kt = k.transpose(0, 2, 3, 1, 4)
    vt = v.transpose(0, 2, 1, 3)
    kpos = jnp.arange(S, dtype=jnp.int32)
    kchunk = kpos // CHUNK
    neg = jnp.finfo(jnp.float32).min

    def block(args):
        qb, bi = args
        qpos = bi * Q_BLOCK + jnp.arange(Q_BLOCK, dtype=jnp.int32)
        bias = rel_bias[rel_bucket(kpos[None, :] - qpos[:, None])]
        bias = bias.transpose(2, 0, 1).astype(jnp.float32)
        allowed = kchunk[None, :] <= (qpos // CHUNK)[:, None]
        s = jnp.einsum("bhmqd,bhmkd->bhmqk", qb, kt).astype(jnp.float32) * scale
        s = s + bias[None, :, None]
        s = jnp.where(allowed[None, None, None], s, neg)
        p = jax.nn.softmax(s, axis=-1)
        a = p[:, :, 0] - lam.astype(jnp.float32) * p[:, :, 1]
        return jnp.einsum("bhqk,bhkd->bhqd", a.astype(vt.dtype), vt)

    o = lax.map(block, (qb_all, jnp.arange(nb, dtype=jnp.int32)))
    return o.transpose(1, 0, 3, 2, 4).reshape(B, S, N_DIFF_HEADS, DIFF_DV)


def multiscale_pool(u, w_pool, scale):
    B, S, _ = u.shape
    uf = u.astype(jnp.float32).reshape(B, S, POOL_GROUPS, POOL_DIM)
    cum = jnp.cumsum(uf, axis=1)
    t1 = jnp.arange(1, S + 1, dtype=jnp.float32)
    outs = []
    for g, w in enumerate(POOL_WINDOWS):
        c = cum[:, :, g]
        lag = jnp.pad(c, ((0, 0), (w, 0), (0, 0)))[:, :S]
        mean = (c - lag) / jnp.minimum(t1, float(w))[None, :, None]
        outs.append(mean - uf[:, :, g])
    d = jnp.stack(outs, axis=2).astype(u.dtype)
    y = jnp.einsum("bsgc,gcd->bsgd", d, w_pool) * scale.reshape(POOL_GROUPS, POOL_DIM)
    return y.reshape(B, S, POOL_WIDTH)


def cross_attention(h, m, wq, wkv, wo):
    B, S, _ = h.shape
    q = (h @ wq).reshape(B, S, N_CROSS_HEADS, CROSS_HEAD_DIM)
    kv = (m @ wkv).reshape(B, m.shape[1], 2, N_CROSS_HEADS, CROSS_HEAD_DIM)
    k, v = kv[:, :, 0], kv[:, :, 1]
    s = jnp.einsum("bqhd,bkhd->bhqk", q, k).astype(jnp.float32) * (CROSS_HEAD_DIM ** -0.5)
    p = jax.nn.softmax(s, axis=-1).astype(v.dtype)
    o = jnp.einsum("bhqk,bkhd->bqhd", p, v).reshape(B, S, D_MODEL)
    return o @ wo


def hier_moe(h, wr_g, br_g, wr_e, br_e, w_gate, w_up, w_down):
    B, S, D = h.shape
    t = h.reshape(B * S, D)
    g_logits = (t @ wr_g + br_g).astype(jnp.float32)
    g_prob = jax.nn.softmax(g_logits, axis=-1)
    g_sel = jnp.argmax(g_logits, axis=-1)
    g_w = jnp.take_along_axis(g_prob, g_sel[:, None], axis=-1)[:, 0]
    e_logits = (jnp.einsum("td,gde->tge", t, wr_e) + br_e).astype(jnp.float32)
    e_sel_logits = jnp.take_along_axis(e_logits, g_sel[:, None, None], axis=1)[:, 0]
    top_v, top_i = lax.top_k(e_sel_logits, TOP_K_INNER)
    top_w = jax.nn.softmax(top_v, axis=-1)
    inner = jnp.einsum("tk,tke->te", top_w, jax.nn.one_hot(top_i, EXPERTS_PER_GROUP, dtype=jnp.float32))
    combine = (g_w[:, None, None] * jax.nn.one_hot(g_sel, N_EXPERT_GROUPS, dtype=jnp.float32)[:, :, None]
               * inner[:, None, :]).reshape(B * S, N_EXPERTS)
    hg = jnp.einsum("td,edf->tef", t, w_gate)
    hu = jnp.einsum("td,edf->tef", t, w_up)
    act = jax.nn.silu(hg) * hu * combine.astype(t.dtype)[:, :, None]
    out = jnp.einsum("tef,efd->td", act, w_down)
    return out.reshape(B, S, D)


def setup_inputs(seed: int = 0) -> dict:
    key = jax.random.key(seed)
    ks = jax.random.split(key, 32)
    f32 = jnp.float32
    nrm = lambda k, shape, s: jax.random.normal(k, shape, f32) * s
    gain = lambda k, shape: 1.0 + 0.05 * jax.random.normal(k, shape, f32)
    L, D = DEPTH, D_MODEL
    return {
        "x": jax.random.normal(ks[0], (BATCH, SEQ, D), f32),
        "mem": jax.random.normal(ks[1], (BATCH, MEM_LEN, D), f32),
        "rel_bias": nrm(ks[2], (REL_BUCKETS, N_DIFF_HEADS), 0.5),
        "attn_norm": gain(ks[3], (L, D)),
        "w_in": nrm(ks[4], (L, D, IN_WIDTH), D ** -0.5),
        "lambda_q1": nrm(ks[5], (L, DIFF_DK), 0.1),
        "lambda_k1": nrm(ks[6], (L, DIFF_DK), 0.1),
        "lambda_q2": nrm(ks[7], (L, DIFF_DK), 0.1),
        "lambda_k2": nrm(ks[8], (L, DIFF_DK), 0.1),
        "diff_subln": gain(ks[9], (L, DIFF_DV)),
        "pool_w": nrm(ks[10], (L, POOL_GROUPS, POOL_DIM, POOL_DIM), POOL_DIM ** -0.5),
        "pool_scale": gain(ks[11], (L, POOL_WIDTH)),
        "w_out": nrm(ks[12], (L, MIX_WIDTH, D), MIX_WIDTH ** -0.5),
        "cross_norm": gain(ks[13], (L, D)),
        "mem_norm": gain(ks[14], (L, D)),
        "wq_cross": nrm(ks[15], (L, D, D), D ** -0.5),
        "wkv_cross": nrm(ks[16], (L, D, 2 * D), D ** -0.5),
        "wo_cross": nrm(ks[17], (L, D, D), D ** -0.5),
        "ffn_norm": gain(ks[18], (L, D)),
        "router_group": nrm(ks[19], (L, D, N_EXPERT_GROUPS), D ** -0.5),
        "router_group_bias": nrm(ks[20], (L, N_EXPERT_GROUPS), 0.01),
        "router_expert": nrm(ks[21], (L, N_EXPERT_GROUPS, D, EXPERTS_PER_GROUP), D ** -0.5),
        "router_expert_bias": nrm(ks[22], (L, N_EXPERT_GROUPS, EXPERTS_PER_GROUP), 0.01),
        "w_gate": nrm(ks[23], (L, N_EXPERTS, D, EXPERT_FF), D ** -0.5),
        "w_up": nrm(ks[24], (L, N_EXPERTS, D, EXPERT_FF), D ** -0.5),
        "w_down": nrm(ks[25], (L, N_EXPERTS, EXPERT_FF, D), EXPERT_FF ** -0.5),
        "final_norm": gain(ks[26], (D,)),
    }


def reference(x, mem, rel_bias, attn_norm, w_in, lambda_q1, lambda_k1, lambda_q2, lambda_k2,
              diff_subln, pool_w, pool_scale, w_out, cross_norm, mem_norm, wq_cross, wkv_cross,
              wo_cross, ffn_norm, router_group, router_group_bias, router_expert,
              router_expert_bias, w_gate, w_up, w_down, final_norm):
    B, S, _ = x.shape
    h = x
    for layer in range(DEPTH):
        lambda_init = 0.8 - 0.6 * math.exp(-0.3 * layer)
        hn = rmsnorm(h, attn_norm[layer])
        z = hn @ w_in[layer]
        q = z[..., :DIFF_WIDTH].reshape(B, S, N_DIFF_HEADS, 2, DIFF_DK)
        k = z[..., DIFF_WIDTH:2 * DIFF_WIDTH].reshape(B, S, N_DIFF_HEADS, 2, DIFF_DK)
        v = z[..., 2 * DIFF_WIDTH:3 * DIFF_WIDTH].reshape(B, S, N_DIFF_HEADS, DIFF_DV)
        u = z[..., 3 * DIFF_WIDTH:]
        lam = (jnp.exp(jnp.sum(lambda_q1[layer] * lambda_k1[layer]))
               - jnp.exp(jnp.sum(lambda_q2[layer] * lambda_k2[layer])) + lambda_init)
        a = diff_attention(q, k, v, lam, rel_bias)
        a = rmsnorm(a, diff_subln[layer]) * (1.0 - lambda_init)
        a = a.reshape(B, S, DIFF_WIDTH)
        p = multiscale_pool(u, pool_w[layer], pool_scale[layer])
        h = h + jnp.concatenate([a, p], axis=-1) @ w_out[layer]
        h = h + cross_attention(rmsnorm(h, cross_norm[layer]), rmsnorm(mem, mem_norm[layer]),
                                wq_cross[layer], wkv_cross[layer], wo_cross[layer])
        h = h + hier_moe(rmsnorm(h, ffn_norm[layer]), router_group[layer], router_group_bias[layer],
                         router_expert[layer], router_expert_bias[layer],
                         w_gate[layer], w_up[layer], w_down[layer])
    return rmsnorm(h, final_norm)
```

```cpp
#include <hip/hip_runtime.h>
#include <cstdio>
#include <cstdint>

#define GAS __attribute__((address_space(1)))
#define LAS __attribute__((address_space(3)))
typedef unsigned short bf16;
typedef short bf16x8 __attribute__((ext_vector_type(8)));
typedef float f32x4 __attribute__((ext_vector_type(4)));
typedef float f32x2 __attribute__((ext_vector_type(2)));
typedef float f32x16 __attribute__((ext_vector_type(16)));
typedef unsigned u32x4 __attribute__((ext_vector_type(4)));
typedef unsigned u32x2 __attribute__((ext_vector_type(2)));
typedef __bf16 bf16x2_t __attribute__((ext_vector_type(2)));

__device__ __forceinline__ unsigned cvtpk(float lo, float hi) { f32x2 v = {lo, hi}; bf16x2_t b = __builtin_convertvector(v, bf16x2_t); return __builtin_bit_cast(unsigned, b); }
__device__ __forceinline__ float bf2f(unsigned short b) { return __builtin_bit_cast(float, (unsigned)b << 16); }
__device__ __forceinline__ float bflo(unsigned w) { return __builtin_bit_cast(float, w << 16); }
__device__ __forceinline__ float bfhi(unsigned w) { return __builtin_bit_cast(float, w & 0xffff0000u); }

__device__ __forceinline__ unsigned pk4_fp8(float a, float b, float c, float d) { int w = 0; w = __builtin_amdgcn_cvt_pk_fp8_f32(a, b, w, false); w = __builtin_amdgcn_cvt_pk_fp8_f32(c, d, w, true); return (unsigned)w; }
typedef int v8i32 __attribute__((ext_vector_type(8))); typedef int v4i32 __attribute__((ext_vector_type(4)));

#ifndef WT_STORES
#define WT_STORES 0
#endif
__device__ __forceinline__ void st16(void* p, u32x4 v) {
#if WT_STORES
    asm volatile("global_store_dwordx4 %0, %1, off sc1\n\ts_nop 1" :: "v"(p), "v"(v) : "memory");
#else
    *(u32x4*)p = v;
#endif
}
__device__ __forceinline__ void st8(void* p, u32x2 v) {
#if WT_STORES
    asm volatile("global_store_dwordx2 %0, %1, off sc1\n\ts_nop 1" :: "v"(p), "v"(v) : "memory");
#else
    *(u32x2*)p = v;
#endif
}

namespace pg8 {
constexpr int BM = 256, BK = 64, HALF = 128, HTB = HALF * BK * 2  , STAGE_BYTES = 8 * HTB, NXCD = 8, WGM = 8;

__host__ __device__ __forceinline__ int lds_byte(int r, int c) { const int st = (r >> 4) * 2 + (c >> 5), rr = r & 15, cc = c & 31, ob = rr * 64 + cc * 2; return st * 1024 + (ob ^ (((ob >> 9) & 1) << 5)); }
__host__ __device__ __forceinline__ void stage_rc(int b, int& R, int& C) { const int st = b / 1024, sb = b % 1024, swz = sb ^ (((sb >> 9) & 1) << 5); R = (st >> 1) * 16 + swz / 64; C = (st & 1) * 32 + (swz % 64) / 2; }
__host__ __device__ __forceinline__ int perm32(int rho) { const int n = rho >> 4, i = rho & 15; return 8 * (i >> 2) + 4 * n + (i & 3); }

struct Unit { int pm, pn, e, row0, nval, lofs; };

template <class Epi, class Sched, bool ALIGN_EPI, bool F8 = false>
__device__ __forceinline__ void gemm_phase(LAS unsigned char* lds, const int K, const Sched& S, const Epi& E) {
    const int tid = threadIdx.x, wid = __builtin_amdgcn_readfirstlane(tid >> 6), lane = tid & 63, wr = wid >> 2, wc = wid & 3, fr = lane & 15, fq = lane >> 4;
    const int nt = K / BK;
    int Rl[2], Cl[2];
    unsigned voffA[2][2], voffAn[2][2], voffB[2][2];
#pragma unroll
    for (int i = 0; i < 2; ++i) { int R, C; stage_rc(tid * 16 + i * 8192, R, C); Rl[i] = R; Cl[i] = C; const int Rb = Epi::PERM ? ((R & ~31) + perm32(R & 31)) : R;
#pragma unroll
        for (int h = 0; h < 2; ++h) { voffB[h][i] = (unsigned)((Rb + HALF * h) * K + C) * 2u; voffA[h][i] = (unsigned)((R + HALF * h) * K + C) * 2u; voffAn[h][i] = voffA[h][i]; } }
    const size_t kstep = (size_t)(BK * 2);
    const unsigned ldsw = (unsigned)wid * 1024u;
    const int aoff = lds_byte(wr * 64 + fr, fq * 8), boff = lds_byte(wc * 32 + fr, fq * 8);
#define PG8_SA(b, h) (((b) * 2 + (h)) * HTB)
#define PG8_SB(b, h) ((4 + (b) * 2 + (h)) * HTB)
#define PG8_STAGE(bufoff, gbase, voff) do { _Pragma("unroll") for (int _i = 0; _i < 2; ++_i) \
        __builtin_amdgcn_global_load_lds((const unsigned*)((const char*)(gbase) + (voff)[_i]), (LAS unsigned*)(lds + (bufoff) + ldsw + _i * 8192), 16, 0, 0); } while (0)
#define PG8_LDA(dst, b, h) do { _Pragma("unroll") for (int m = 0; m < 4; ++m) { dst[m].lo = *(const LAS v4i32*)(lds + PG8_SA(b, h) + aoff + m * 2048); dst[m].hi = *(const LAS v4i32*)(lds + PG8_SA(b, h) + aoff + m * 2048 + 1024); } } while (0)
#define PG8_LDB(dst, b, h) do { _Pragma("unroll") for (int n = 0; n < 2; ++n) { dst[n].lo = *(const LAS v4i32*)(lds + PG8_SB(b, h) + boff + n * 2048); dst[n].hi = *(const LAS v4i32*)(lds + PG8_SB(b, h) + boff + n * 2048 + 1024); } } while (0)
#define PG8_CAT(x) __builtin_shufflevector((x).lo, (x).hi, 0, 1, 2, 3, 4, 5, 6, 7)
#define PG8_MMA(ai, bj, At, Bt) do { __builtin_amdgcn_s_setprio(1); _Pragma("unroll") for (int m = 0; m < 4; ++m) _Pragma("unroll") for (int n = 0; n < 2; ++n) { \
        if constexpr (F8) { const v8i32 b8_ = PG8_CAT(Bt[n]), a8_ = PG8_CAT(At[m]); asm volatile("v_mfma_f32_16x16x128_f8f6f4 %0, %1, %2, %0" : "+v"(acc[ai][bj][m][n]) : "v"(b8_), "v"(a8_)); } \
        else { acc[ai][bj][m][n] = __builtin_amdgcn_mfma_f32_16x16x32_bf16(__builtin_bit_cast(bf16x8, Bt[n].lo), __builtin_bit_cast(bf16x8, At[m].lo), acc[ai][bj][m][n], 0, 0, 0); \
               acc[ai][bj][m][n] = __builtin_amdgcn_mfma_f32_16x16x32_bf16(__builtin_bit_cast(bf16x8, Bt[n].hi), __builtin_bit_cast(bf16x8, At[m].hi), acc[ai][bj][m][n], 0, 0, 0); } } \
        __builtin_amdgcn_s_setprio(0); } while (0)
#define PG8_WAIT_V(n) asm volatile("s_waitcnt vmcnt(" #n ")" ::: "memory")
#define PG8_WAIT_L(n) asm volatile("s_waitcnt lgkmcnt(" #n ")" ::: "memory")
#define PG8_BAR __builtin_amdgcn_s_barrier()
#define PG8_SCHED __builtin_amdgcn_sched_barrier(0)
    Unit cur, nxt; int ui = 0;
    if (!S.next(0, cur)) return;
    if constexpr (Sched::GATHER) S.gather(cur, Rl, Cl, K, voffA);
    f32x4 acc[2][2][4][2];
#pragma unroll
    for (int a = 0; a < 2; ++a)
#pragma unroll
        for (int b = 0; b < 2; ++b)
#pragma unroll
            for (int m = 0; m < 4; ++m)
#pragma unroll
                for (int n = 0; n < 2; ++n) acc[a][b][m][n] = (f32x4){0.f, 0.f, 0.f, 0.f};
    struct Frag { v4i32 lo, hi; }; Frag At[4], B0[2], B1[2];
    const char* cA = S.a_base(cur); const char* cB = S.b_base(cur);
    PG8_STAGE(PG8_SB(0, 0), cB, voffB[0]); PG8_STAGE(PG8_SB(0, 1), cB, voffB[1]); PG8_STAGE(PG8_SA(0, 0), cA, voffA[0]); PG8_STAGE(PG8_SA(0, 1), cA, voffA[1]);
    if (wr == 1) PG8_BAR;
    PG8_WAIT_V(2); PG8_BAR;
    PG8_STAGE(PG8_SB(1, 0), cB + kstep, voffB[0]); PG8_STAGE(PG8_SA(1, 0), cA + kstep, voffA[0]); PG8_STAGE(PG8_SB(1, 1), cB + kstep, voffB[1]);
    PG8_WAIT_V(6); PG8_BAR;
    for (;;) {
        const bool has_next = S.next(ui + 1, nxt);
        const char* nA = has_next ? S.a_base(nxt) : cA; const char* nB = has_next ? S.b_base(nxt) : cB;
        if constexpr (Sched::GATHER) { if (has_next) S.gather(nxt, Rl, Cl, K, voffAn); else {
#pragma unroll
            for (int h = 0; h < 2; ++h)
#pragma unroll
                for (int i = 0; i < 2; ++i) voffAn[h][i] = voffA[h][i]; } }
#pragma clang loop unroll(disable)
        for (int t = 0; t < nt; t += 2) {
            const bool last = (t == nt - 2);
            const char* a1 = cA + (size_t)(t + 1) * kstep;
            const char* a2 = last ? nA : cA + (size_t)(t + 2) * kstep; const char* b2 = last ? nB : cB + (size_t)(t + 2) * kstep;
            const char* a3 = a2 + kstep; const char* b3 = b2 + kstep;
            unsigned vA2[2][2];
#pragma unroll
            for (int h = 0; h < 2; ++h)
#pragma unroll
                for (int i = 0; i < 2; ++i) vA2[h][i] = (Sched::GATHER && last) ? voffAn[h][i] : voffA[h][i];
            PG8_LDB(B0, 0, 0); PG8_LDB(B1, 0, 1); PG8_SCHED; PG8_LDA(At, 0, 0); PG8_STAGE(PG8_SA(1, 1), a1, voffA[1]);
            PG8_WAIT_V(8); PG8_WAIT_L(0); PG8_BAR; PG8_MMA(0, 0, At, B0); PG8_MMA(0, 1, At, B1); PG8_BAR; PG8_SCHED;
            PG8_LDA(At, 0, 1); PG8_STAGE(PG8_SB(0, 0), b2, voffB[0]); PG8_STAGE(PG8_SB(0, 1), b2, voffB[1]); PG8_STAGE(PG8_SA(0, 0), a2, vA2[0]);
            PG8_WAIT_V(8); PG8_WAIT_L(0); PG8_BAR; PG8_MMA(1, 0, At, B0); PG8_MMA(1, 1, At, B1); PG8_BAR; PG8_SCHED;
            PG8_LDB(B0, 1, 0); PG8_LDB(B1, 1, 1); PG8_SCHED; PG8_LDA(At, 1, 0); PG8_STAGE(PG8_SA(0, 1), a2, vA2[1]);
            PG8_WAIT_V(8); PG8_WAIT_L(0); PG8_BAR; PG8_MMA(0, 0, At, B0); PG8_MMA(0, 1, At, B1); PG8_BAR; PG8_SCHED;
            PG8_LDA(At, 1, 1); PG8_STAGE(PG8_SB(1, 0), b3, voffB[0]); PG8_STAGE(PG8_SB(1, 1), b3, voffB[1]); PG8_STAGE(PG8_SA(1, 0), a3, vA2[0]);
            PG8_WAIT_V(8); PG8_WAIT_L(0); PG8_BAR; PG8_MMA(1, 0, At, B0); PG8_MMA(1, 1, At, B1); PG8_BAR; PG8_SCHED;
        }
        if constexpr (ALIGN_EPI) { if (wr == 0) PG8_BAR; }
        if constexpr (!Epi::AFTER_DRAIN) { E(acc, cur, wr, wc, fr, fq); }
        if (!has_next) break;
#pragma unroll
        for (int a = 0; a < 2; ++a)
#pragma unroll
            for (int b = 0; b < 2; ++b)
#pragma unroll
                for (int m = 0; m < 4; ++m)
#pragma unroll
                    for (int n = 0; n < 2; ++n) acc[a][b][m][n] = (f32x4){0.f, 0.f, 0.f, 0.f};
        cur = nxt; cA = nA; cB = nB; ++ui;
        if constexpr (Sched::GATHER) {
#pragma unroll
            for (int h = 0; h < 2; ++h)
#pragma unroll
                for (int i = 0; i < 2; ++i) voffA[h][i] = voffAn[h][i]; }
        if constexpr (ALIGN_EPI) { if (wr == 1) PG8_BAR; }
    }
    PG8_WAIT_V(0);
    if constexpr (!ALIGN_EPI) { if (wr == 0) PG8_BAR; }
    PG8_BAR;
    if constexpr (Epi::AFTER_DRAIN) { E.fused(acc, cur, wr, wc, fr, fq, lds, wid, lane); }
#undef PG8_SA
#undef PG8_SB
#undef PG8_STAGE
#undef PG8_LDA
#undef PG8_LDB
#undef PG8_MMA
#undef PG8_WAIT_V
#undef PG8_WAIT_L
#undef PG8_BAR
#undef PG8_SCHED
}

struct DenseOrder {
    static constexpr bool GATHER = false;
    const char* A; const char* B; int K; size_t bbatch; int nM, nN, nwg, G, c;
    __device__ void init(const void* A_, const void* B_, int M, int N, int K_, size_t bbatch_, int G_, int c_) { A = (const char*)A_; B = (const char*)B_; K = K_; bbatch = bbatch_; nM = M / BM; nN = N / BM; nwg = nM * nN; G = G_; c = c_; }
    __device__ __forceinline__ bool next(int i, Unit& u) const {
        const long L = (long)i * G + c; if (L >= nwg) return false;
        int wgid = (int)L; { const int q = nwg / NXCD, r = nwg % NXCD, xcd = wgid % NXCD, off = wgid / NXCD; wgid = (xcd < r ? xcd * (q + 1) : r * (q + 1) + (xcd - r) * q) + off; }
        const int nig = WGM * nN, gid = wgid / nig, fm = gid * WGM, gsz = (nM - fm) < WGM ? (nM - fm) : WGM;
        u.pm = fm + ((wgid % nig) % gsz); u.pn = (wgid % nig) / gsz; u.e = 0; u.row0 = 0; u.nval = 256; u.lofs = 0; return true;
    }
    __device__ __forceinline__ const char* a_base(const Unit& u) const { return A + (size_t)u.pm * ((size_t)BM * K * 2); }
    __device__ __forceinline__ const char* b_base(const Unit& u) const { return B + (u.pm >= 32 ? bbatch : (size_t)0) + (size_t)u.pn * ((size_t)BM * K * 2); }
    __device__ __forceinline__ void gather(const Unit&, const int (&)[2], const int (&)[2], int, unsigned (&)[2][2]) const {}
};
}
namespace dat {
constexpr int SEQ = 8192, ZP = 2048;
constexpr int KSLOT = 8192, VSLOT = 8192, NKS = 8, NVS = 8, L_V = NKS * KSLOT, L_TAB = L_V + NVS * VSLOT, LDS_BYTES = L_TAB + 1024;
constexpr int KT_BLOCK = 16384;
constexpr float LOG2E = 1.4426950408889634f;
__device__ __forceinline__ void glds16(const void* gsrc, unsigned lds_dst) { unsigned keep;
    asm volatile("s_mov_b32 %0, m0\n\ts_mov_b32 m0, %2\n\ts_nop 0\n\tglobal_load_lds_dwordx4 %1, off\n\ts_mov_b32 m0, %0" : "=&s"(keep) : "v"(gsrc), "s"(lds_dst) : "memory"); }
#define DAT_WAIT_BAR(N) asm volatile("s_waitcnt vmcnt(" #N ") lgkmcnt(0)\n\ts_barrier" ::: "memory")
#define DAT_SB() __builtin_amdgcn_sched_barrier(0)
typedef short v4i16_t __attribute__((ext_vector_type(4)));
typedef short s16x4 __attribute__((ext_vector_type(4)));
__device__ __forceinline__ s16x4 vtr(LAS const char* p) { return __builtin_bit_cast(s16x4, __builtin_amdgcn_ds_read_tr16_b64_v4i16((LAS v4i16_t*)p)); }
__device__ __forceinline__ float max3f(float a, float b, float c) { float r; asm("v_max3_f32 %0, %1, %2, %3" : "=v"(r) : "v"(a), "v"(b), "v"(c)); return r; }
__device__ __forceinline__ float max2f(float a, float b) { float r; asm("v_max_f32_e32 %0, %1, %2" : "=v"(r) : "v"(a), "v"(b)); return r; }

__device__ __forceinline__ int rel_bucket(int rel) {
    const int n = rel < 0 ? -rel : rel; int b = rel > 0 ? 16 : 0;
    int l = n < 8 ? n : (n >= 91 ? 15 : n >= 64 ? 14 : n >= 46 ? 13 : n >= 32 ? 12 : n >= 23 ? 11 : n >= 16 ? 10 : n >= 12 ? 9 : 8);
    return b + l;
}

struct VFrag { v4i32 lo, hi; };
__device__ __forceinline__ void vread(VFrag& v, LAS const char* vp, int d) { v.lo = *(LAS const v4i32*)(vp + d * 2048); v.hi = *(LAS const v4i32*)(vp + d * 2048 + 16); }
template <bool SKIP = false>
__device__ __forceinline__ void pvmma(f32x16& o, const VFrag& v, const v8i32& pf) {
    if (SKIP) return;
    o = __builtin_amdgcn_mfma_scale_f32_32x32x64_f8f6f4(__builtin_shufflevector(v.lo, v.hi, 0, 1, 2, 3, 4, 5, 6, 7), pf, o, 0, 0, 0, 0, 0, 0);
}
__device__ __forceinline__ void kread(VFrag (&kf)[2], LAS const char* kp) {
#pragma unroll
    for (int j = 0; j < 2; ++j) { kf[j].lo = *(LAS const v4i32*)(kp + j * 512); kf[j].hi = *(LAS const v4i32*)(kp + 1024 + j * 512); }
}
template <bool COMP>
__device__ __forceinline__ void qkmma(f32x16& p0, f32x16& p1, const VFrag (&kf)[2], const v8i32& qf, const v8i32& ql, const f32x16& negm) {
    const v8i32 k0 = __builtin_shufflevector(kf[0].lo, kf[0].hi, 0, 1, 2, 3, 4, 5, 6, 7), k1 = __builtin_shufflevector(kf[1].lo, kf[1].hi, 0, 1, 2, 3, 4, 5, 6, 7);
    p0 = __builtin_amdgcn_mfma_scale_f32_32x32x64_f8f6f4(k0, qf, negm, 0, 0, 0, 0, 0, 0);
    p1 = __builtin_amdgcn_mfma_scale_f32_32x32x64_f8f6f4(k1, qf, negm, 0, 0, 0, 0, 0, 0);
    if constexpr (COMP) { p0 = __builtin_amdgcn_mfma_scale_f32_32x32x64_f8f6f4(k0, ql, p0, 0, 0, 0, 0, 0, 0); p1 = __builtin_amdgcn_mfma_scale_f32_32x32x64_f8f6f4(k1, ql, p1, 0, 0, 0, 0, 0, 0); }
}
template <int THRL>
__device__ __forceinline__ void softmax_max(bool first, f32x16& p0, f32x16& p1, f32x16& negm, float& mrun, f32x16& ol, f32x16 (&o)[4], bool near, int ib, LAS const float* tab) {
    if (near) {
#pragma unroll
        for (int r = 0; r < 16; ++r) { const int kk = (r & 3) + 8 * (r >> 2); p0[r] += tab[ib + kk]; p1[r] += tab[ib + kk + 32]; }
    }
    float ma = max3f(p0[0], p0[1], p0[2]), mb = max3f(p1[0], p1[1], p1[2]);
    ma = max3f(ma, p0[3], p0[4]); mb = max3f(mb, p1[3], p1[4]);
#pragma unroll
    for (int r = 5; r < 15; r += 2) { ma = max3f(ma, p0[r], p0[r + 1]); mb = max3f(mb, p1[r], p1[r + 1]); }
    float rm = max3f(ma, mb, p0[15]); rm = max2f(rm, p1[15]);
    { auto rr = __builtin_amdgcn_permlane32_swap(__float_as_uint(rm), __float_as_uint(rm), false, false); rm = max2f(__uint_as_float(rr[0]), __uint_as_float(rr[1])); }
    if (first || __any(rm > (float)THRL)) {
        const float dl = first ? rm : __builtin_fmaxf(rm, 0.f); mrun += dl;
        const float f = first ? 1.0f : __builtin_amdgcn_exp2f(-dl); ol[0] *= f;
#pragma unroll
        for (int r = 0; r < 16; ++r) { p0[r] -= dl; p1[r] -= dl; negm[r] = -mrun; }
#pragma unroll
        for (int d = 0; d < 4; ++d)
#pragma unroll
            for (int r = 0; r < 16; ++r) o[d][r] *= f;
    }
}
template <bool NOEXP = false>
__device__ __forceinline__ void softmax_exp(f32x16& p0, f32x16& p1, v8i32& pf) {
#define DAT_E2(x) (NOEXP ? (x) : __builtin_amdgcn_exp2f(x))
#pragma unroll
    for (int g = 0; g < 4; ++g) {
        const float e0 = DAT_E2(p0[4 * g]), e1 = DAT_E2(p0[4 * g + 1]), e2 = DAT_E2(p0[4 * g + 2]), e3 = DAT_E2(p0[4 * g + 3]);
        pf[g] = (int)pk4_fp8(e0, e1, e2, e3); DAT_SB();
    }
#pragma unroll
    for (int g = 0; g < 4; ++g) {
        const float e0 = DAT_E2(p1[4 * g]), e1 = DAT_E2(p1[4 * g + 1]), e2 = DAT_E2(p1[4 * g + 2]), e3 = DAT_E2(p1[4 * g + 3]);
        pf[4 + g] = (int)pk4_fp8(e0, e1, e2, e3); DAT_SB();
    }
}

struct Ctx { const unsigned char* tsrc; unsigned kdst, vdst; int wid, NT, tl, q0w, r32, hi; LAS const char* kp0; LAS const char* vp0; LAS const float* tab; };
#define DAT_DMA_K(C, t) glds16((C).tsrc + (size_t)(t) * KT_BLOCK, (unsigned)__builtin_amdgcn_readfirstlane((C).kdst + ((t) & 7) * KSLOT))
#define DAT_DMA_V(C, t) glds16((C).tsrc + (size_t)(t) * KT_BLOCK + 8192, (unsigned)__builtin_amdgcn_readfirstlane((C).vdst + ((t) & 7) * VSLOT))
#define DAT_WINDOW(C, t) do { if (MODE != 2) DAT_WAIT_BAR(0); if (MODE != 1 && MODE != 2 && (t) + 2 < (C).NT) { DAT_DMA_V(C, (t) + 2); DAT_DMA_K(C, (t) + 3); DAT_DMA_V(C, (t) + 3); if ((t) + 4 < (C).NT) DAT_DMA_K(C, (t) + 4); } } while (0)

#define DAT_VBLK(c0, c1, tau) do { \
        const int tau_ = (tau); \
        if (tau_ + 1 <= C.tl && MODE != 5) kread(kf, C.kp0 + ((tau_ + 1) & 7) * KSLOT); \
        DAT_SB(); \
        if (tau_ <= C.tl) { const bool near = 64 * tau_ > C.q0w - 191; const int ib = 64 * tau_ - C.q0w + 191 - C.r32 + 4 * C.hi; \
            int fv = (tau_ == 0); asm volatile("" : "+v"(fv)); const int fl = __builtin_amdgcn_readfirstlane(fv); \
            softmax_max<THRL>(fl != 0, c0, c1, negm, mrun, ol, o, near, ib, C.tab); DAT_SB(); \
            if (MODE != 5) vread(vA, C.vp0 + (tau_ & 7) * VSLOT, 0); DAT_SB(); \
            softmax_exp<MODE == 3>(c0, c1, pf); } \
        DAT_SB(); \
    } while (0)
#define DAT_MBLK(c0, c1, tau) do { \
        const int tau_ = (tau); \
        if (tau_ + 1 <= C.tl) qkmma<COMP>(c0, c1, kf, qf, ql, negm); \
        DAT_SB(); \
        if (tau_ <= C.tl) { LAS const char* vp = C.vp0 + (tau_ & 7) * VSLOT; VFrag vB = {}; \
            ol = __builtin_amdgcn_mfma_scale_f32_32x32x64_f8f6f4(ones, pf, ol, 0, 0, 0, 0, 0, 0); \
            DAT_SB(); if (MODE != 5) vread(vB, vp, 1); DAT_SB(); pvmma<MODE == 4>(o[0], vA, pf); DAT_SB(); \
            if (MODE != 5) vread(vA, vp, 2); DAT_SB(); pvmma<MODE == 4>(o[1], vB, pf); DAT_SB(); \
            if (MODE != 5) vread(vB, vp, 3); DAT_SB(); pvmma<MODE == 4>(o[2], vA, pf); DAT_SB(); \
            pvmma<MODE == 4>(o[3], vB, pf); DAT_SB(); } \
    } while (0)
template <int THRL, bool COMP, bool LAG, int MODE>
__device__ __forceinline__ void loop_p(const Ctx& C, const v8i32& qf, const v8i32& ql, f32x16 (&o)[4], float& lsum) {
    float mrun = 0.f; f32x16 negm = f32x16{}; v8i32 pf = v8i32{}; f32x16 ol = f32x16{};
    const int onew = C.r32 == 0 ? 0x38383838 : 0; const v8i32 ones = (v8i32){onew, onew, onew, onew, onew, onew, onew, onew};
    f32x16 a0, a1; VFrag kf[2] = {}, vA = {};
    DAT_WINDOW(C, 0);
    if (MODE != 5) kread(kf, C.kp0); DAT_SB(); qkmma<COMP>(a0, a1, kf, qf, ql, negm); DAT_SB();
    asm volatile("s_nop 15\n\ts_nop 7" : "+v"(a0), "+v"(a1));
    if constexpr (!LAG) {
        for (int t = 0;; t += 2) {
            DAT_VBLK(a0, a1, t); DAT_MBLK(a0, a1, t); DAT_VBLK(a0, a1, t + 1); DAT_MBLK(a0, a1, t + 1);
            if (t + 2 >= C.NT) break;
            DAT_WINDOW(C, t + 2);
        }
    } else {
        DAT_VBLK(a0, a1, 0); DAT_MBLK(a0, a1, 0); DAT_VBLK(a0, a1, 1);
        for (int t = 2; t < C.NT; t += 2) {
            DAT_WINDOW(C, t);
            DAT_MBLK(a0, a1, t - 1); DAT_VBLK(a0, a1, t); DAT_MBLK(a0, a1, t); DAT_VBLK(a0, a1, t + 1);
        }
        DAT_MBLK(a0, a1, C.NT - 1);
    }
    lsum = ol[0];
}
template <int THRL, int MODE = 0>
__device__ __forceinline__ void attn_unit(int b, int h, int xb, const bf16* __restrict__ Z, const unsigned char* __restrict__ KT, bf16* __restrict__ A2, const float* __restrict__ rel_bias, const float* __restrict__ subln, float lam, LAS char* shm) {
    int tid = threadIdx.x; asm volatile("" : "+v"(tid));
    const int lane = tid & 63, r32 = lane & 31, hi = lane >> 5; const int wid = __builtin_amdgcn_readfirstlane(tid >> 6);
    const int mp = wid >> 2, rw = wid & 3;
    const long rowbase = (long)b * SEQ; const int q0 = xb * 128, q0w = q0 + 32 * rw;
    const unsigned lds0 = (unsigned)(uintptr_t)shm;
    LAS float* tab = (LAS float*)(shm + L_TAB);
    { int tv = tid; asm volatile("" : "+v"(tv));
      if (tv < 255) { const int rel = tv - 191; tab[tv] = (rel_bias[rel_bucket(rel) * 4 + h] - rel_bias[15 * 4 + h]) * LOG2E; } }
    const bf16* Qw = Z + (rowbase + q0w + r32) * ZP + h * 128 + mp * 64 + hi * 32;
    v8i32 qf, ql;
#pragma unroll
    for (int ks = 0; ks < 4; ++ks) { const u32x4 qq = *(const u32x4*)(Qw + 8 * ks);
        const float q0 = bflo(qq.x), q1 = bfhi(qq.x), q2 = bflo(qq.y), q3 = bfhi(qq.y), q4 = bflo(qq.z), q5 = bfhi(qq.z), q6 = bflo(qq.w), q7 = bfhi(qq.w);
        const int a = (int)pk4_fp8(q0, q1, q2, q3), c = (int)pk4_fp8(q4, q5, q6, q7); qf[2 * ks] = a; qf[2 * ks + 1] = c;
        ql[2 * ks] = (int)pk4_fp8(q0 - __builtin_amdgcn_cvt_f32_fp8(a, 0), q1 - __builtin_amdgcn_cvt_f32_fp8(a, 1), q2 - __builtin_amdgcn_cvt_f32_fp8(a, 2), q3 - __builtin_amdgcn_cvt_f32_fp8(a, 3));
        ql[2 * ks + 1] = (int)pk4_fp8(q4 - __builtin_amdgcn_cvt_f32_fp8(c, 0), q5 - __builtin_amdgcn_cvt_f32_fp8(c, 1), q6 - __builtin_amdgcn_cvt_f32_fp8(c, 2), q7 - __builtin_amdgcn_cvt_f32_fp8(c, 3)); }
    asm volatile("" : "+v"(qf), "+v"(ql));
    Ctx C;
    C.tsrc = KT + (size_t)((b * 4 + h) * 128) * KT_BLOCK + wid * 1024 + lane * 16;
    C.kdst = lds0 + wid * 1024; C.vdst = lds0 + L_V + wid * 1024; C.wid = wid;
    C.NT = 2 * (xb + 1);
    C.tl = q0w >> 6;
    C.q0w = q0w; C.r32 = r32; C.hi = hi; C.tab = tab;
    C.kp0 = (LAS const char*)shm + mp * 4096 + hi * 2048 + r32 * 16;
    C.vp0 = (LAS const char*)shm + L_V + hi * 1024 + r32 * 32;
    if (MODE != 1 && MODE != 2) { DAT_DMA_K(C, 0); DAT_DMA_K(C, 1); DAT_DMA_V(C, 0); DAT_DMA_V(C, 1); if (C.NT > 2) DAT_DMA_K(C, 2); }
    float lsum = 0.f;
    f32x16 o[4]; o[0] = f32x16{}; o[1] = f32x16{}; o[2] = f32x16{}; o[3] = f32x16{};
    if (mp == 0) loop_p<THRL, true, false, MODE>(C, qf, ql, o, lsum); else loop_p<THRL, false, true, MODE>(C, qf, ql, o, lsum);
    { auto rr = __builtin_amdgcn_permlane32_swap(__float_as_uint(lsum), __float_as_uint(lsum), false, false); lsum = __uint_as_float(rr[0]) + __uint_as_float(rr[1]); }
    const float inv = 1.0f / lsum;
    DAT_WAIT_BAR(0);
    LAS float* ex = (LAS float*)shm + rw * 4096 + lane;
    if (mp == 1) {
        const float sc = inv * lam;
#pragma unroll
        for (int d = 0; d < 4; ++d)
#pragma unroll
            for (int r = 0; r < 16; ++r) ex[(d * 16 + r) * 64] = o[d][r] * sc;
    }
    DAT_WAIT_BAR(0);
    if (mp == 0) {
        float ss = 0.f;
#pragma unroll
        for (int d = 0; d < 4; ++d)
#pragma unroll
            for (int r = 0; r < 16; ++r) { const float a = o[d][r] * inv - ex[(d * 16 + r) * 64]; o[d][r] = a; ss += a * a; }
        { auto rr = __builtin_amdgcn_permlane32_swap(__float_as_uint(ss), __float_as_uint(ss), false, false); ss = __uint_as_float(rr[0]) + __uint_as_float(rr[1]); }
        const float rs = 0.8f / __builtin_sqrtf(ss * (1.0f / 128.0f) + 1e-6f);
        bf16* orow = A2 + (rowbase + q0w + r32) * 1024 + h * 128 + 4 * hi;
#pragma unroll
        for (int d = 0; d < 4; ++d)
#pragma unroll
            for (int g = 0; g < 4; ++g) {
                const f32x4 gn = *(const f32x4*)(subln + 32 * d + 8 * g + 4 * hi);
                u32x2 w; w.x = cvtpk(o[d][4 * g] * rs * gn[0], o[d][4 * g + 1] * rs * gn[1]); w.y = cvtpk(o[d][4 * g + 2] * rs * gn[2], o[d][4 * g + 3] * rs * gn[3]);
                st8(orow + 32 * d + 8 * g, w);
            }
    }
    DAT_WAIT_BAR(0);
}
}
constexpr int NWAVES = 8;
constexpr int BATCH = 2, SEQ = 8192, D = 1024, M = BATCH * SEQ, MEM = 256, NEXP = 16, FF = 256;
constexpr float EPS = 1e-6f, LOG2E = 1.4426950408889634f;
constexpr float C2 = 0.125f * LOG2E;
constexpr float CX = 0.0625f * LOG2E;
#ifndef MK_N_LAUNCHES
#define MK_N_LAUNCHES 1
#endif
constexpr int N_PHASES = 10;

constexpr size_t MiB = 1u << 20;
constexpr size_t WS_CTL = 0, CTL_ZERO_BYTES = 65536;
constexpr size_t WS_SSQ1 = 1 * MiB, WS_SSQ2 = 2 * MiB, WS_LIST = 3 * MiB, WS_LISTR = 4 * MiB, WS_LISTW = 5 * MiB, WS_WR = 6 * MiB  , WS_MN = 7 * MiB, WS_KVC = 8 * MiB;
constexpr size_t WS_WINT = 10 * MiB, WS_WOUTT = 14 * MiB, WS_WQN = 16 * MiB, WS_WKVT = 18 * MiB, WS_WOT = 22 * MiB, WS_WGUT = 24 * MiB, WS_WDT = 40 * MiB, WS_BTS = 48 * MiB, WS_BTO = 52 * MiB;
constexpr size_t WS_RA = 56 * MiB;
constexpr size_t WS_RB = 88 * MiB;
constexpr size_t WS_RC = 152 * MiB;
constexpr size_t WS_RD = 184 * MiB;
constexpr size_t WS_XB = 216 * MiB;
constexpr size_t WS_WGUT8 = 248 * MiB;
constexpr size_t WS_END = 256 * MiB;
constexpr size_t WS_WTMP = WS_BTS;
constexpr size_t WS_PWS = WS_BTO;
constexpr size_t WS_RSX = WS_SSQ2;
constexpr int CW_BAR = 4096, XCD_BAR_WORDS_C = 3456;
static_assert(CW_BAR + XCD_BAR_WORDS_C <= 8192 && (8192 + 16 * 64) * 4 <= 65536, "control words inside the memset region");
constexpr int CW_PAN = 9216;
static_assert((CW_PAN + 3 * 64 * 16) * 4 <= 65536, "panel counters inside the memset region");
constexpr int CW_XCC = 12288;
constexpr int CW_CNT = 8192;

constexpr int RING_OFF = 0, RING_BYTES = 148480;
constexpr int LDSCTL_OFF = RING_BYTES, MISC_OFF = LDSCTL_OFF + 320;
constexpr int LTAB_OFF = LDSCTL_OFF + 1024;
constexpr int LDS_BYTES = 163840;
static_assert(dat::LDS_BYTES <= RING_BYTES, "attention scratch inside the ring region");

typedef GAS unsigned gu32;
#define RLX_AGENT __ATOMIC_RELAXED, __HIP_MEMORY_SCOPE_AGENT
#define LDS_WAIT() asm volatile("s_waitcnt lgkmcnt(0)" ::: "memory")
#define VM_WAIT() asm volatile("s_waitcnt vmcnt(0)" ::: "memory")

#define XB_TMO      128
#define XB_XCNT(j)  (256  + 64 * (j))
#define XB_XSUB(j)  (1280 + 64 * (j))
#define XB_XGEN(j)  (2304 + 64 * (j))
#define XB_TOP      3328
#define XB_TOPGEN   3392
#define XCD_BAR_WORDS 3456
#define XB_SPIN_CAP (1u << 18)

__device__ __forceinline__ unsigned xb_ld(unsigned* p)              { return __hip_atomic_load(p, __ATOMIC_RELAXED, __HIP_MEMORY_SCOPE_AGENT); }
__device__ __forceinline__ unsigned xb_add(unsigned* p, unsigned v) { return __hip_atomic_fetch_add(p, v, __ATOMIC_RELAXED, __HIP_MEMORY_SCOPE_AGENT); }
__device__ __forceinline__ unsigned xb_xcc_id() { return (unsigned)__builtin_amdgcn_s_getreg((3 << 11) | 20) & 0xFu; }
#define XB_SPIN(cond, bar) do { unsigned _sp = 0; while (cond) { __builtin_amdgcn_s_sleep(1); \
    if ((++_sp & 255u) == 0u) { if (xb_ld(&(bar)[XB_TMO])) break; if (_sp > XB_SPIN_CAP) { atomicAdd(&(bar)[XB_TMO], 1u); break; } } } } while (0)

struct XcdBarrier {
    unsigned* bar; unsigned x;
    volatile LAS unsigned* st;
};
__device__ __forceinline__ XcdBarrier xcd_barrier_post(unsigned* bar, volatile LAS unsigned* st) {
    XcdBarrier b; b.bar = bar; b.x = xb_xcc_id(); b.st = st;
    if (threadIdx.x == 0) (void)xb_add(&bar[XB_XCNT(b.x)], 1u);
    return b;
}
__device__ __forceinline__ void xcd_barrier_complete(unsigned* bar, unsigned x, unsigned& nloc, unsigned& nx) {
    const unsigned G = gridDim.x * gridDim.y * gridDim.z;
    unsigned sum, cnt, mine, sp = 0u;
    for (;;) {
        sum = 0u; cnt = 0u; mine = 0u;
#pragma unroll
        for (unsigned j = 0; j < 16; ++j) { const unsigned c = xb_ld(&bar[XB_XCNT(j)]); sum += c; cnt += (c > 0u) ? 1u : 0u; mine = (j == x) ? c : mine; }
        if (sum == G) break;
        __builtin_amdgcn_s_sleep(1);
        if ((++sp & 255u) == 0u) { if (xb_ld(&bar[XB_TMO])) break; if (sp > XB_SPIN_CAP) { atomicAdd(&bar[XB_TMO], 1u); break; } }
    }
    nloc = mine > 0u ? mine : 1u; nx = cnt > 0u ? cnt : 1u;
}
__device__ __forceinline__ void xcd_barrier(const XcdBarrier& b) {
    asm volatile("s_waitcnt vmcnt(0)" ::: "memory");
    __syncthreads();
    if (threadIdx.x == 0) {
        unsigned* bar = b.bar;
        __builtin_amdgcn_s_waitcnt(0);
        unsigned nloc = b.st[0], nx = b.st[1];
        if (nloc == 0u) { xcd_barrier_complete(bar, b.x, nloc, nx); b.st[0] = nloc; b.st[1] = nx; }
        const unsigned old = xb_add(&bar[XB_XSUB(b.x)], 1u);
        const unsigned gen = old / nloc;
        if (old + 1u == (gen + 1u) * nloc) {
            __builtin_amdgcn_fence(__ATOMIC_RELEASE, "agent");
            asm volatile("s_waitcnt vmcnt(0)" ::: "memory");
            const unsigned og = xb_add(&bar[XB_TOP], 1u);
            const unsigned tg = og / nx;
            if (og + 1u == (tg + 1u) * nx) xb_add(&bar[XB_TOPGEN], 1u);
            else XB_SPIN(xb_ld(&bar[XB_TOPGEN]) == tg, bar);
            __builtin_amdgcn_fence(__ATOMIC_ACQUIRE, "agent");
            xb_add(&bar[XB_XGEN(b.x)], 1u);
            asm volatile("s_waitcnt vmcnt(0)" ::: "memory");
        } else {
            XB_SPIN(xb_ld(&bar[XB_XGEN(b.x)]) == gen, bar);
            __builtin_amdgcn_fence(__ATOMIC_ACQUIRE, "agent");
            asm volatile("s_waitcnt vmcnt(0)" ::: "memory");
        }
    }
    __syncthreads();
}

__device__ __forceinline__ void panel_signal(unsigned* cnt, bool local) {
    asm volatile("s_waitcnt vmcnt(0)" ::: "memory");
    __syncthreads();
    if (threadIdx.x == 0) { if (!local) { __builtin_amdgcn_fence(__ATOMIC_RELEASE, "agent"); asm volatile("s_waitcnt vmcnt(0)" ::: "memory"); } (void)xb_add(cnt, 1u); }
}
__device__ __forceinline__ void panel_wait(unsigned* cnt, unsigned need, unsigned* tmo) {
    if (threadIdx.x == 0) { XB_SPIN(xb_ld(cnt) < need, tmo - XB_TMO); __builtin_amdgcn_fence(__ATOMIC_ACQUIRE, "agent"); asm volatile("s_waitcnt vmcnt(0)" ::: "memory"); }
    __syncthreads();
}

struct Frame {
    LAS unsigned char* lds;
    volatile LAS unsigned* MISC;
    gu32* ctl;
    int tid, lane, wave;
    int vcu, G;
    const float* in[27]; float* out; unsigned char* ws;
};
enum { I_X = 0, I_MEM, I_RELB, I_ANORM, I_WIN, I_LQ1, I_LK1, I_LQ2, I_LK2, I_SUBLN, I_POOLW, I_POOLS, I_WOUT, I_CNORM, I_MNORM, I_WQ, I_WKV, I_WO, I_FNORM, I_RG, I_RGB, I_RE, I_REB, I_WG, I_WU, I_WD, I_FINAL };

__device__ __forceinline__ float wave_sum(float v) {
#pragma unroll
    for (int o = 1; o < 64; o <<= 1) v += __shfl_xor(v, o);
    return v;
}

__device__ __forceinline__ void p0_transpose_load(float (&v)[32], const float* W, int ldw, int k0, int n0, int lane) {
    const float* src = W + (size_t)(k0 + (lane >> 5)) * ldw + n0 + (lane & 31);
#pragma unroll
    for (int i = 0; i < 32; ++i) v[i] = __builtin_nontemporal_load(src + (size_t)(2 * i) * ldw);
}
__device__ __forceinline__ void p0_transpose_store(float (&v)[32], int k0, bf16* WT, int ldt, int drow0, int dcol0, const float* gain, LAS float* scr, int lane, unsigned char* WT8 = nullptr, float s8 = 1.f) {
    if (gain) {
#pragma unroll
        for (int i = 0; i < 32; ++i) v[i] *= gain[k0 + 2 * i + (lane >> 5)]; }
#pragma unroll
    for (int i = 0; i < 32; ++i) scr[(2 * i + (lane >> 5)) * 33 + (lane & 31)] = v[i];
    LDS_WAIT(); asm volatile("" ::: "memory");
    const int c = lane & 7;
#pragma unroll
    for (int j = 0; j < 4; ++j) { const int n = (lane >> 3) + 8 * j; const LAS float* s = scr + (8 * c) * 33 + n;
        u32x4 o; o.x = cvtpk(s[0 * 33], s[1 * 33]); o.y = cvtpk(s[2 * 33], s[3 * 33]); o.z = cvtpk(s[4 * 33], s[5 * 33]); o.w = cvtpk(s[6 * 33], s[7 * 33]);
        if (WT) *(GAS u32x4*)(WT + (size_t)(drow0 + n) * ldt + dcol0 + 8 * c) = o;
        if (WT8) { u32x2 o8; o8.x = pk4_fp8(s[0 * 33] * s8, s[1 * 33] * s8, s[2 * 33] * s8, s[3 * 33] * s8); o8.y = pk4_fp8(s[4 * 33] * s8, s[5 * 33] * s8, s[6 * 33] * s8, s[7 * 33] * s8);
            *(GAS u32x2*)(WT8 + (size_t)(drow0 + n) * ldt + dcol0 + 8 * c) = o8; } }
    LDS_WAIT(); asm volatile("" ::: "memory");
}
__device__ __forceinline__ void p0_transpose_item(const float* W, int ldw, int k0, int n0, bf16* WT, int ldt, int drow0, int dcol0, const float* gain, LAS float* scr, int lane) {
    float v[32]; p0_transpose_load(v, W, ldw, k0, n0, lane); p0_transpose_store(v, k0, WT, ldt, drow0, dcol0, gain, scr, lane);
}
template <int NR>
__device__ __forceinline__ void rms_rows_to_bf16(const float* xrow, const float* g, bf16* orow, int lane) {
    const GAS f32x4* gr = (const GAS f32x4*)g + lane;
    f32x4 v[NR][4]; float s[NR];
#pragma unroll
    for (int r = 0; r < NR; ++r) { const GAS f32x4* xr = (const GAS f32x4*)(xrow + (size_t)r * D) + lane;
#pragma unroll
        for (int j = 0; j < 4; ++j) v[r][j] = __builtin_nontemporal_load(xr + 64 * j); }
#pragma unroll
    for (int r = 0; r < NR; ++r) { s[r] = 0.f;
#pragma unroll
        for (int j = 0; j < 4; ++j) s[r] += (v[r][j].x * v[r][j].x + v[r][j].y * v[r][j].y) + (v[r][j].z * v[r][j].z + v[r][j].w * v[r][j].w); }
#pragma unroll
    for (int r = 0; r < NR; ++r) { const float rstd = 1.f / __builtin_sqrtf(wave_sum(s[r]) * (1.f / D) + EPS);
        GAS u32x2* o8 = (GAS u32x2*)(orow + (size_t)r * D) + lane;
#pragma unroll
        for (int j = 0; j < 4; ++j) { const f32x4 gg = gr[64 * j]; u32x2 w; w.x = cvtpk(v[r][j].x * rstd * gg.x, v[r][j].y * rstd * gg.y); w.y = cvtpk(v[r][j].z * rstd * gg.z, v[r][j].w * rstd * gg.w); o8[64 * j] = w; } }
}

template <int NR>
__device__ __forceinline__ void rows_to_bf16_rstd(const float* xrow, bf16* orow, float* rstd_out, int lane) {
    f32x4 v[NR][4]; float s[NR];
#pragma unroll
    for (int r = 0; r < NR; ++r) { const GAS f32x4* xr = (const GAS f32x4*)(xrow + (size_t)r * D) + lane;
#pragma unroll
        for (int j = 0; j < 4; ++j) v[r][j] = __builtin_nontemporal_load(xr + 64 * j); }
#pragma unroll
    for (int r = 0; r < NR; ++r) { s[r] = 0.f; GAS u32x2* o8 = (GAS u32x2*)(orow + (size_t)r * D) + lane;
#pragma unroll
        for (int j = 0; j < 4; ++j) { s[r] += (v[r][j].x * v[r][j].x + v[r][j].y * v[r][j].y) + (v[r][j].z * v[r][j].z + v[r][j].w * v[r][j].w);
            u32x2 w; w.x = cvtpk(v[r][j].x, v[r][j].y); w.y = cvtpk(v[r][j].z, v[r][j].w); o8[64 * j] = w; } }
#pragma unroll
    for (int r = 0; r < NR; ++r) { const float t = wave_sum(s[r]); if (lane == 0) rstd_out[r] = 1.f / __builtin_sqrtf(t * (1.f / D) + EPS); }
}

template <int KS = 8, class Store>
__device__ __forceinline__ void small_gemm64(const bf16* A, int lda, const bf16* B, int ldb, int K, int wave, int lane, const Store& st) {
    const int fr = lane & 15, fq = lane >> 4;
    const bf16* ap = A + (size_t)(16 * (wave & 3) + fr) * lda + 8 * fq;
    const bf16* bp0 = B + (size_t)(32 * (wave >> 2) + fr) * ldb + 8 * fq;
    const bf16* bp1 = bp0 + (size_t)16 * ldb;
    f32x4 acc0 = {0.f, 0.f, 0.f, 0.f}, acc1 = {0.f, 0.f, 0.f, 0.f};
    for (int k = 0; k < K; k += 32 * KS) {
        bf16x8 a[KS], b0[KS], b1[KS];
#pragma unroll
        for (int s = 0; s < KS; ++s) { a[s] = *(const GAS bf16x8*)(ap + k + 32 * s); b0[s] = *(const GAS bf16x8*)(bp0 + k + 32 * s); b1[s] = *(const GAS bf16x8*)(bp1 + k + 32 * s); }
#pragma unroll
        for (int s = 0; s < KS; ++s) { acc0 = __builtin_amdgcn_mfma_f32_16x16x32_bf16(b0[s], a[s], acc0, 0, 0, 0); acc1 = __builtin_amdgcn_mfma_f32_16x16x32_bf16(b1[s], a[s], acc1, 0, 0, 0); }
    }
    const int row = 16 * (wave & 3) + fr, col = 32 * (wave >> 2) + 4 * fq;
    st(row, col, acc0); st(row, col + 16, acc1);
}
struct TileJob { const bf16* A; const bf16* B; bf16* C; int lda, ldb, ldc; int c8; };
template <class Get> struct PlainJobs { Get get;
    __device__ __forceinline__ const bf16* arow(int j, int lane) const { const TileJob t = get(j); return t.A + (size_t)lane * t.lda; }
    __device__ __forceinline__ const bf16* brow(int j, int lane) const { const TileJob t = get(j); return t.B + (size_t)lane * t.ldb; }
    __device__ __forceinline__ void store(int j, int wave, int lane, f32x4 acc0, f32x4 acc1) const { const TileJob t = get(j);
        if (t.c8) { unsigned char* c8p = (unsigned char*)t.C + (size_t)(16 * (wave & 3) + (lane & 15)) * t.ldc + 32 * (wave >> 2) + 4 * (lane >> 4);
            *(GAS unsigned*)c8p = pk4_fp8(acc0[0], acc0[1], acc0[2], acc0[3]); *(GAS unsigned*)(c8p + 16) = pk4_fp8(acc1[0], acc1[1], acc1[2], acc1[3]); return; }
        bf16* cp = t.C + (size_t)(16 * (wave & 3) + (lane & 15)) * t.ldc + 32 * (wave >> 2) + 4 * (lane >> 4);
        u32x2 w; w.x = cvtpk(acc0[0], acc0[1]); w.y = cvtpk(acc0[2], acc0[3]); *(GAS u32x2*)cp = w; w.x = cvtpk(acc1[0], acc1[1]); w.y = cvtpk(acc1[2], acc1[3]); *(GAS u32x2*)(cp + 16) = w; }
};
template <int KCH, int NSTEP, bool F8 = false, class Jobs>
__device__ __forceinline__ void tile_pipe(LAS char* lds, int njobs, const Jobs& jobs, int wave, int lane) {
    constexpr int CPR = KCH / 8, RPP = 64 / CPR, ROWB = CPR * 16, OPB = 64 * ROWB, BUFB = 2 * OPB, PPO = 64 / RPP / 8;
    const unsigned lds0 = (unsigned)(uintptr_t)lds; const int fr = lane & 15, fq = lane >> 4;
    const int nsteps = njobs * NSTEP;
    if (nsteps <= 0) return;
    const int rip = lane / CPR, slot = lane % CPR;
    const bf16* ar_[PPO]; const bf16* br_[PPO];
#define TP_DMA(st, buf) do { const int k0_ = ((st) % NSTEP) * KCH; \
        if (k0_ == 0) { _Pragma("unroll") for (int i_ = 0; i_ < PPO; ++i_) { const int row_ = (wave * PPO + i_) * RPP + rip; const int ch_ = (slot & 16) | ((slot ^ row_) & 15); \
            ar_[i_] = jobs.arow((st) / NSTEP, row_) + 8 * ch_; br_[i_] = jobs.brow((st) / NSTEP, row_) + 8 * ch_; } } \
        _Pragma("unroll") for (int i_ = 0; i_ < PPO; ++i_) { \
            dat::glds16(ar_[i_] + k0_, (unsigned)__builtin_amdgcn_readfirstlane(lds0 + (buf) * BUFB + (wave * PPO + i_) * 1024)); \
            dat::glds16(br_[i_] + k0_, (unsigned)__builtin_amdgcn_readfirstlane(lds0 + (buf) * BUFB + OPB + (wave * PPO + i_) * 1024)); } } while (0)
    TP_DMA(0, 0);
    f32x4 acc0 = {0.f, 0.f, 0.f, 0.f}, acc1 = {0.f, 0.f, 0.f, 0.f};
    const int x0 = fq ^ fr;
    const int aoff = (16 * (wave & 3) + fr) * ROWB, boff = OPB + (32 * (wave >> 2) + fr) * ROWB;
    for (int st = 0; st < nsteps; ++st) {
        asm volatile("s_waitcnt vmcnt(0) lgkmcnt(0)\n\ts_barrier" ::: "memory");
        if (st + 1 < nsteps) TP_DMA(st + 1, (st + 1) & 1);
        LAS const char* bp = lds + (st & 1) * BUFB;
        if constexpr (F8) {
#pragma unroll
            for (int s3 = 0; s3 < KCH / 64; ++s3) {
                const int so0 = ((((8 * s3) ^ x0) & 15) | ((8 * s3) & 16)) * 16, so1 = ((((8 * s3 + 4) ^ x0) & 15) | ((8 * s3 + 4) & 16)) * 16;
                const v4i32 al = *(LAS const v4i32*)(bp + aoff + so0), ah = *(LAS const v4i32*)(bp + aoff + so1), b0l = *(LAS const v4i32*)(bp + boff + so0), b0h = *(LAS const v4i32*)(bp + boff + so1),
                            b1l = *(LAS const v4i32*)(bp + boff + 16 * ROWB + so0), b1h = *(LAS const v4i32*)(bp + boff + 16 * ROWB + so1);
                const v8i32 a8 = __builtin_shufflevector(al, ah, 0, 1, 2, 3, 4, 5, 6, 7), b08 = __builtin_shufflevector(b0l, b0h, 0, 1, 2, 3, 4, 5, 6, 7), b18 = __builtin_shufflevector(b1l, b1h, 0, 1, 2, 3, 4, 5, 6, 7);
                acc0 = __builtin_amdgcn_mfma_scale_f32_16x16x128_f8f6f4(b08, a8, acc0, 0, 0, 0, 0, 0, 0); acc1 = __builtin_amdgcn_mfma_scale_f32_16x16x128_f8f6f4(b18, a8, acc1, 0, 0, 0, 0, 0, 0);
            }
        } else {
#pragma unroll
        for (int s2 = 0; s2 < KCH / 32; ++s2) {
            const int so = ((((4 * s2) ^ x0) & 15) | ((4 * s2) & 16)) * 16;
            const bf16x8 a = *(LAS const bf16x8*)(bp + aoff + so), b0 = *(LAS const bf16x8*)(bp + boff + so), b1 = *(LAS const bf16x8*)(bp + boff + 16 * ROWB + so);
            acc0 = __builtin_amdgcn_mfma_f32_16x16x32_bf16(b0, a, acc0, 0, 0, 0); acc1 = __builtin_amdgcn_mfma_f32_16x16x32_bf16(b1, a, acc1, 0, 0, 0);
        }
        }
        if ((st % NSTEP) == NSTEP - 1) { jobs.store(st / NSTEP, wave, lane, acc0, acc1); acc0 = (f32x4){0.f, 0.f, 0.f, 0.f}; acc1 = (f32x4){0.f, 0.f, 0.f, 0.f}; }
    }
    asm volatile("s_waitcnt vmcnt(0) lgkmcnt(0)\n\ts_barrier" ::: "memory");
#undef TP_DMA
}
struct StoreBf16 { bf16* C; int ldc;
    __device__ __forceinline__ void operator()(int row, int col, f32x4 v) const { u32x2 w; w.x = cvtpk(v[0], v[1]); w.y = cvtpk(v[2], v[3]); *(GAS u32x2*)(C + (size_t)row * ldc + col) = w; } };
namespace pg8 {
struct EpiBf16 { static constexpr bool PERM = true, AFTER_DRAIN = false; bf16* O; int ldc; int scale_cols; float scale0;
    __device__ __forceinline__ void operator()(const f32x4 (&acc)[2][2][4][2], const Unit& u, int wr, int wc, int fr, int fq) const {
        const int row0 = u.pm * BM + wr * 64 + fr, colt = u.pn * BM; const float sc = colt < scale_cols ? scale0 : 1.f; const int col0 = colt + wc * 32 + 8 * fq;
#pragma unroll
        for (int ai = 0; ai < 2; ++ai)
#pragma unroll
            for (int m = 0; m < 4; ++m) { bf16* rowp = O + (size_t)(row0 + ai * HALF + m * 16) * ldc + col0;
#pragma unroll
                for (int bj = 0; bj < 2; ++bj) { const f32x4 v0 = acc[ai][bj][m][0] * sc, v1 = acc[ai][bj][m][1] * sc;
                    u32x4 w; w.x = cvtpk(v0[0], v0[1]); w.y = cvtpk(v0[2], v0[3]); w.z = cvtpk(v1[0], v1[1]); w.w = cvtpk(v1[2], v1[3]); st16(rowp + bj * HALF, w); } }
    }
};
struct EpiZ { static constexpr bool PERM = true, AFTER_DRAIN = false; bf16* Z; unsigned char* KT; float qscale; const float* rsx; LAS unsigned char* vscr;
    __device__ __forceinline__ void operator()(const f32x4 (&acc)[2][2][4][2], const Unit& u, int wr, int wc, int fr, int fq) const {
        const int kind = u.pn >> 1;
        float rs[2][4];
#pragma unroll
        for (int ai = 0; ai < 2; ++ai)
#pragma unroll
            for (int m = 0; m < 4; ++m) rs[ai][m] = rsx[u.pm * BM + ai * HALF + wr * 64 + m * 16 + fr];
        if (kind == 0 || kind == 3) {
            const int row0 = u.pm * BM + wr * 64 + fr, col0 = u.pn * BM + wc * 32 + 8 * fq; const float sc = kind == 0 ? qscale : 1.f;
#pragma unroll
            for (int ai = 0; ai < 2; ++ai)
#pragma unroll
                for (int m = 0; m < 4; ++m) { bf16* rowp = Z + (size_t)(row0 + ai * HALF + m * 16) * 2048 + col0; const float sr = sc * rs[ai][m];
#pragma unroll
                    for (int bj = 0; bj < 2; ++bj) { const f32x4 v0 = acc[ai][bj][m][0] * sr, v1 = acc[ai][bj][m][1] * sr;
                        u32x4 w; w.x = cvtpk(v0[0], v0[1]); w.y = cvtpk(v0[2], v0[3]); w.z = cvtpk(v1[0], v1[1]); w.w = cvtpk(v1[2], v1[3]); st16(rowp + bj * HALF, w); } }
        } else if (kind == 1) {
            const int b = u.pm >> 5, t0 = (u.pm & 31) * 4 + wr;
            const unsigned inb = (unsigned)((wc >> 1) * 4096 + ((wc & 1) * 2 + (fq >> 1)) * 1024 + fr * 16 + 8 * (fq & 1));
#pragma unroll
            for (int bj = 0; bj < 2; ++bj) { const int h = (u.pn & 1) * 2 + bj;
#pragma unroll
                for (int ai = 0; ai < 2; ++ai) { unsigned char* blk = KT + (size_t)(((b * 4 + h) * 128) + t0 + 2 * ai) * 16384 + inb;
#pragma unroll
                    for (int m = 0; m < 4; ++m) { const f32x4 v0 = acc[ai][bj][m][0] * rs[ai][m], v1 = acc[ai][bj][m][1] * rs[ai][m];
                        u32x2 w; w.x = pk4_fp8(v0[0], v0[1], v0[2], v0[3]); w.y = pk4_fp8(v1[0], v1[1], v1[2], v1[3]); st8(blk + m * 256, w); } } }
        } else {
            const int b = u.pm >> 5, t0 = (u.pm & 31) * 4 + wr; const int wave = wr * 4 + wc;
            LAS unsigned char* sc = vscr + wave * 2048; const int hik = (fr >> 2) & 1, r0 = (fr & 3) + 4 * (fr >> 3);
#pragma unroll
            for (int bj = 0; bj < 2; ++bj) { const int h = (u.pn & 1) * 2 + bj;
#pragma unroll
                for (int ai = 0; ai < 2; ++ai) {
#pragma unroll
                    for (int m = 0; m < 4; ++m) { const int bb = 16 * (m >> 1) + r0 + 8 * (m & 1);
#pragma unroll
                        for (int n = 0; n < 2; ++n)
#pragma unroll
                            for (int i = 0; i < 4; ++i) { const float x = acc[ai][bj][m][n][i] * rs[ai][m]; const int w = __builtin_amdgcn_cvt_pk_fp8_f32(x, x, 0, false);
                                sc[hik * 1024 + (8 * fq + 4 * n + i) * 32 + bb] = (unsigned char)w; } }
                    asm volatile("s_waitcnt lgkmcnt(0)" ::: "memory");
                    const int lane = fq * 16 + fr; const u32x4 o0 = *(const LAS u32x4*)(sc + lane * 32), o1 = *(const LAS u32x4*)(sc + lane * 32 + 16);
                    unsigned char* blk = KT + (size_t)(((b * 4 + h) * 128) + t0 + 2 * ai) * 16384 + 8192 + wc * 2048 + lane * 32;
                    st16(blk, o0); st16(blk + 16, o1);
                    asm volatile("s_waitcnt lgkmcnt(0)" ::: "memory"); } }
        }
    }
};
template <bool BASE_BF16, bool OUT8 = false> struct EpiRes { static constexpr bool PERM = true, AFTER_DRAIN = false; const void* base; bf16* outb; float* ssq; unsigned char* out8; float ascale;
    __device__ __forceinline__ void operator()(const f32x4 (&acc)[2][2][4][2], const Unit& u, int wr, int wc, int fr, int fq) const {
        const int row0 = u.pm * BM + wr * 64 + fr, col0 = u.pn * BM + wc * 32 + 8 * fq;
#pragma unroll
        for (int ai = 0; ai < 2; ++ai)
#pragma unroll
            for (int m = 0; m < 4; ++m) { const int row = row0 + ai * HALF + m * 16; const size_t off = (size_t)row * 1024 + col0; float ss = 0.f;
#pragma unroll
                for (int bj = 0; bj < 2; ++bj) { f32x4 b0, b1;
                    if (BASE_BF16) { const u32x4 bw = *(const u32x4*)((const bf16*)base + off + bj * HALF); b0 = (f32x4){bflo(bw.x), bfhi(bw.x), bflo(bw.y), bfhi(bw.y)}; b1 = (f32x4){bflo(bw.z), bfhi(bw.z), bflo(bw.w), bfhi(bw.w)}; }
                    else { b0 = *(const f32x4*)((const float*)base + off + bj * HALF); b1 = *(const f32x4*)((const float*)base + off + bj * HALF + 4); }
                    const f32x4 v0 = acc[ai][bj][m][0] * ascale + b0, v1 = acc[ai][bj][m][1] * ascale + b1;
                    u32x4 w; w.x = cvtpk(v0[0], v0[1]); w.y = cvtpk(v0[2], v0[3]); w.z = cvtpk(v1[0], v1[1]); w.w = cvtpk(v1[2], v1[3]); st16(outb + off + bj * HALF, w);
                    if constexpr (OUT8) { u32x2 w8; w8.x = pk4_fp8(v0[0], v0[1], v0[2], v0[3]); w8.y = pk4_fp8(v1[0], v1[1], v1[2], v1[3]); *(u32x2*)(out8 + off + bj * HALF) = w8; }
                    ss += (v0[0] * v0[0] + v0[1] * v0[1]) + (v0[2] * v0[2] + v0[3] * v0[3]) + (v1[0] * v1[0] + v1[1] * v1[1]) + (v1[2] * v1[2] + v1[3] * v1[3]); }
                ss += __shfl_xor(ss, 16); ss += __shfl_xor(ss, 32);
                if (fq == 0) ssq[(size_t)row * 16 + u.pn * 4 + wc] = ss;
                if (m == 3) asm volatile("" ::: "memory"); }
    }
};
struct EpiSoftmax { static constexpr bool PERM = true, AFTER_DRAIN = true; const float* ssq; unsigned char* P;
    __device__ __forceinline__ void operator()(const f32x4 (&)[2][2][4][2], const Unit&, int, int, int, int) const {}
    __device__ __forceinline__ void fused(f32x4 (&acc)[2][2][4][2], const Unit& u, int wr, int wc, int fr, int fq, LAS unsigned char* lds, int wid, int lane) const {
        LAS float* PM = (LAS float*)lds; LAS float* PS = PM + 1024;
#pragma unroll
        for (int ai = 0; ai < 2; ++ai)
#pragma unroll
            for (int m = 0; m < 4; ++m) { const int rt = ai * HALF + wr * 64 + m * 16 + fr; const f32x4* sp = (const f32x4*)(ssq + (size_t)(u.pm * BM + rt) * 16);
                const f32x4 s0 = sp[0], s1 = sp[1], s2 = sp[2], s3 = sp[3]; const f32x4 st = (s0 + s1) + (s2 + s3);
                const float rs = CX / __builtin_sqrtf(((st[0] + st[1]) + (st[2] + st[3])) * (1.0f / 1024.0f) + EPS);
                float mx = -3.0e38f;
#pragma unroll
                for (int bj = 0; bj < 2; ++bj)
#pragma unroll
                    for (int n = 0; n < 2; ++n) { f32x4 v = acc[ai][bj][m][n] * rs; acc[ai][bj][m][n] = v; mx = __builtin_fmaxf(mx, __builtin_fmaxf(__builtin_fmaxf(v[0], v[1]), __builtin_fmaxf(v[2], v[3]))); }
                mx = __builtin_fmaxf(mx, __shfl_xor(mx, 16)); mx = __builtin_fmaxf(mx, __shfl_xor(mx, 32));
                if (fq == 0) PM[rt * 4 + wc] = mx; }
        asm volatile("s_waitcnt lgkmcnt(0)" ::: "memory"); __builtin_amdgcn_s_barrier(); asm volatile("" ::: "memory");
#pragma unroll
        for (int ai = 0; ai < 2; ++ai)
#pragma unroll
            for (int m = 0; m < 4; ++m) { const int rt = ai * HALF + wr * 64 + m * 16 + fr; const f32x4 m4 = *(const LAS f32x4*)(PM + rt * 4);
                const float mx = __builtin_fmaxf(__builtin_fmaxf(m4[0], m4[1]), __builtin_fmaxf(m4[2], m4[3])); float sm = 0.f;
#pragma unroll
                for (int bj = 0; bj < 2; ++bj)
#pragma unroll
                    for (int n = 0; n < 2; ++n) { f32x4 v = acc[ai][bj][m][n]; v[0] = __builtin_amdgcn_exp2f(v[0] - mx); v[1] = __builtin_amdgcn_exp2f(v[1] - mx); v[2] = __builtin_amdgcn_exp2f(v[2] - mx); v[3] = __builtin_amdgcn_exp2f(v[3] - mx);
                        acc[ai][bj][m][n] = v; sm += (v[0] + v[1]) + (v[2] + v[3]); }
                sm += __shfl_xor(sm, 16); sm += __shfl_xor(sm, 32);
                if (fq == 0) PS[rt * 4 + wc] = sm; }
        asm volatile("s_waitcnt lgkmcnt(0)" ::: "memory"); __builtin_amdgcn_s_barrier(); asm volatile("" ::: "memory");
        const int col0 = u.pn * BM + wc * 32 + 8 * fq;
#pragma unroll
        for (int ai = 0; ai < 2; ++ai)
#pragma unroll
            for (int m = 0; m < 4; ++m) { const int rt = ai * HALF + wr * 64 + m * 16 + fr; const f32x4 s4 = *(const LAS f32x4*)(PS + rt * 4);
                const float inv = 256.0f / ((s4[0] + s4[1]) + (s4[2] + s4[3])); unsigned char* rowp = P + (size_t)(u.pm * BM + rt) * 1024 + col0;
#pragma unroll
                for (int bj = 0; bj < 2; ++bj) { const f32x4 v0 = acc[ai][bj][m][0] * inv, v1 = acc[ai][bj][m][1] * inv;
                    u32x2 w; w.x = pk4_fp8(v0[0], v0[1], v0[2], v0[3]); w.y = pk4_fp8(v1[0], v1[1], v1[2], v1[3]); *(u32x2*)(rowp + bj * HALF) = w; } }
    }
};
struct EpiGateUp { static constexpr bool PERM = true, AFTER_DRAIN = false; unsigned char* ACT; const float* listr; const float* listw; float ascale;
    __device__ __forceinline__ void operator()(const f32x4 (&acc)[2][2][4][2], const Unit& u, int wr, int wc, int fr, int fq) const {
#pragma unroll
        for (int ai = 0; ai < 2; ++ai)
#pragma unroll
            for (int m = 0; m < 4; ++m) { const int r = ai * HALF + wr * 64 + m * 16 + fr; const bool ok = r < u.nval;
                const float rs = ok ? listr[u.lofs + r] * ascale : 0.f, cw = ok ? listw[u.lofs + r] * 8.0f : 0.f; f32x4 a[2];
#pragma unroll
                for (int n = 0; n < 2; ++n)
#pragma unroll
                    for (int i = 0; i < 4; ++i) { const float g = acc[ai][0][m][n][i] * rs, up = acc[ai][1][m][n][i] * rs; a[n][i] = __builtin_amdgcn_fmed3f(g * __builtin_amdgcn_rcpf(1.0f + __builtin_amdgcn_exp2f(-g * LOG2E)) * up * cw, -448.0f, 448.0f); }
                u32x2 w; w.x = pk4_fp8(a[0][0], a[0][1], a[0][2], a[0][3]); w.y = pk4_fp8(a[1][0], a[1][1], a[1][2], a[1][3]);
                st8(ACT + (size_t)(u.row0 + r) * 256 + u.pn * HALF + wc * 32 + 8 * fq, w); }
    }
};
struct EpiDown { static constexpr bool PERM = true, AFTER_DRAIN = false; unsigned char* YS; const int* list; float ascale;
    __device__ __forceinline__ void operator()(const f32x4 (&acc)[2][2][4][2], const Unit& u, int wr, int wc, int fr, int fq) const {
        const unsigned colp = (unsigned)(u.pn * BM + wc * 32 + 8 * fq); const int* lp = list + u.lofs + wr * 64 + fr;
#pragma unroll
        for (int ai = 0; ai < 2; ++ai)
#pragma unroll
            for (int m = 0; m < 4; ++m) { const int r = ai * HALF + wr * 64 + m * 16 + fr;
                if (r < u.nval) { const unsigned v = (unsigned)lp[ai * HALF + m * 16]; const unsigned eo = ((((v & 1u) << 14) + (v >> 1)) << 10) + colp;
#pragma unroll
                    for (int bj = 0; bj < 2; ++bj) { const f32x4 v0 = acc[ai][bj][m][0] * ascale, v1 = acc[ai][bj][m][1] * ascale;
                        u32x2 w; w.x = pk4_fp8(__builtin_amdgcn_fmed3f(v0[0], -448.f, 448.f), __builtin_amdgcn_fmed3f(v0[1], -448.f, 448.f), __builtin_amdgcn_fmed3f(v0[2], -448.f, 448.f), __builtin_amdgcn_fmed3f(v0[3], -448.f, 448.f));
                        w.y = pk4_fp8(__builtin_amdgcn_fmed3f(v1[0], -448.f, 448.f), __builtin_amdgcn_fmed3f(v1[1], -448.f, 448.f), __builtin_amdgcn_fmed3f(v1[2], -448.f, 448.f), __builtin_amdgcn_fmed3f(v1[3], -448.f, 448.f)); st8(YS + eo + bj * HALF, w); } }
                asm volatile("" ::: "memory"); }
    }
};

template <int NCT, bool GATH> struct MoeOrder {
    static constexpr bool GATHER = GATH;
    LAS const int* tab; const char* A; const char* B; const int* list; int G, c, nunits; size_t bexp, btile; size_t apitch = FF * 2;
    __device__ __forceinline__ bool next(int i, Unit& u) const {
        const int L = i * G + c; if (L >= nunits) return false;
        const int rtg = L / NCT; int e = 0;
#pragma unroll
        for (int j = 1; j < 16; ++j) e += (rtg >= tab[64 + j]) ? 1 : 0;
        e = __builtin_amdgcn_readfirstlane(e);
        const int ptf = __builtin_amdgcn_readfirstlane(tab[64 + e]), pt = __builtin_amdgcn_readfirstlane(tab[e]); const int rt = rtg - ptf;
        u.pm = rt; u.pn = L % NCT; u.e = e; u.row0 = (pt + rt) * 256; u.nval = 256; u.lofs = e * 16384 + rt * 256; return true;
    }
    __device__ __forceinline__ const char* a_base(const Unit& u) const { return GATH ? A : A + (size_t)u.row0 * apitch; }
    __device__ __forceinline__ const char* b_base(const Unit& u) const { return B + (size_t)u.e * bexp + (size_t)u.pn * btile; }
    __device__ __forceinline__ void gather(const Unit& u, const int (&Rl)[2], const int (&Cl)[2], int K, unsigned (&vo)[2][2]) const {
#pragma unroll
        for (int h = 0; h < 2; ++h)
#pragma unroll
            for (int i = 0; i < 2; ++i) { const int r = Rl[i] + HALF * h; const int tok = list[u.lofs + r] >> 1; vo[h][i] = (unsigned)(tok * K + Cl[i]) * 2u; }
    }
};
}

__device__ __forceinline__ void p0_prologue(Frame& F) {
    LAS float* scr = (LAS float*)(F.lds + RING_OFF + F.wave * 16384);
    const int gw = F.vcu * NWAVES + F.wave, NGW = F.G * NWAVES, lane = F.lane;
    unsigned char* ws = F.ws;
    constexpr int N_A = 1024, N_B = 512, N_C = 1024, N_D = 512, N_H = 2048, N_I = 128, N_J = 512;
    constexpr int NITEMS = N_A + N_B + N_C + N_D + N_H + N_I + N_J;
    for (int m = gw; m < BATCH * MEM; m += NGW) rms_rows_to_bf16<1>(F.in[I_MEM] + (size_t)m * D, F.in[I_MNORM], (bf16*)(ws + WS_MN) + (size_t)m * D, lane);
    for (int m = 2 * gw; m < M; m += 2 * NGW) rows_to_bf16_rstd<2>(F.in[I_X] + (size_t)m * D, (bf16*)(ws + WS_XB) + (size_t)m * D, (float*)(ws + WS_RSX) + m, lane);
    for (int it = gw; it < NITEMS; it += NGW) {
        int r = it;
        if (r < N_A) { p0_transpose_item(F.in[I_WIN], 2048, (r >> 6) * 64, (r & 63) * 32, (bf16*)(ws + WS_WINT), 1024, (r & 63) * 32, (r >> 6) * 64, F.in[I_ANORM], scr, lane); continue; } r -= N_A;
        if (r < N_B) { const int k0 = (r >> 5) * 64, n0 = (r & 31) * 32;
            if (k0 < 512) p0_transpose_item(F.in[I_WOUT], 1024, k0, n0, (bf16*)(ws + WS_WOUTT), 1024, n0, k0, nullptr, scr, lane);
            else p0_transpose_item(F.in[I_WOUT], 1024, k0, n0, (bf16*)(ws + WS_WTMP), 512, n0, k0 - 512, nullptr, scr, lane);
            continue; } r -= N_B;
        if (r < N_C) { p0_transpose_item(F.in[I_WKV], 2048, (r >> 6) * 64, (r & 63) * 32, (bf16*)(ws + WS_WKVT), 1024, (r & 63) * 32, (r >> 6) * 64, nullptr, scr, lane); continue; } r -= N_C;
        if (r < N_D) { p0_transpose_item(F.in[I_WO], 1024, (r >> 5) * 64, (r & 31) * 32, (bf16*)(ws + WS_WOT), 1024, (r & 31) * 32, (r >> 5) * 64, nullptr, scr, lane); continue; } r -= N_D;
        if (r < N_H) { const int k = r >> 1, c0 = (r & 1) * 512 + lane * 8; const float g = F.in[I_CNORM][k]; const float* src = F.in[I_WQ] + (size_t)k * 1024 + c0;
            const f32x4 a = __builtin_nontemporal_load((const f32x4*)src) * g, b = __builtin_nontemporal_load((const f32x4*)(src + 4)) * g; u32x4 w; w.x = cvtpk(a[0], a[1]); w.y = cvtpk(a[2], a[3]); w.z = cvtpk(b[0], b[1]); w.w = cvtpk(b[2], b[3]);
            *(u32x4*)((bf16*)(ws + WS_WQN) + (size_t)k * 1024 + c0) = w; continue; } r -= N_H;
        if (r < N_I) { const int e0 = r * 512 + lane * 8;
            const float* pw = F.in[I_POOLW] + e0; const float* ps = F.in[I_POOLS] + (e0 >> 14) * 128 + (e0 & 127);
            const f32x4 a = *(const f32x4*)pw * *(const f32x4*)ps, b = *(const f32x4*)(pw + 4) * *(const f32x4*)(ps + 4);
            u32x4 w; w.x = cvtpk(a[0], a[1]); w.y = cvtpk(a[2], a[3]); w.z = cvtpk(b[0], b[1]); w.w = cvtpk(b[2], b[3]);
            *(u32x4*)((bf16*)(ws + WS_PWS) + e0) = w; continue; } r -= N_I;
        { const int idx = r * 64 + lane, j = idx >> 10, k = idx & 1023;
            float v = 0.f; if (j < 16) v = F.in[I_RE][((size_t)(j >> 2) * 1024 + k) * 4 + (j & 3)]; else if (j < 20) v = F.in[I_RG][(size_t)k * 4 + (j - 16)];
            v *= F.in[I_FNORM][k]; const unsigned hi = cvtpk(v, 0.f) & 0xffffu; const unsigned lo = cvtpk(v - bflo(hi), 0.f) & 0xffffu;
            ((bf16*)(ws + WS_WR))[idx] = (bf16)hi; ((bf16*)(ws + WS_WR + 65536))[idx] = (bf16)lo; }
    }
}

template <int W>
__device__ __forceinline__ void pool_unit_w(int b, int g, int xb, const bf16* Z, bf16* A2, int tid) {
    const int cv = tid & 15, rg = tid >> 4, t0 = xb * 128 + 4 * rg;
    const bf16* up = Z + ((size_t)b * SEQ + t0) * 2048 + 1536 + g * 128 + 8 * cv; bf16* op = A2 + ((size_t)b * SEQ + t0) * 1024 + 512 + g * 128 + 8 * cv;
    u32x4 x[W + 3];
#pragma unroll
    for (int i = 0; i < W + 3; ++i) { const int dt = i - (W - 1); x[i] = (t0 + dt >= 0) ? *(const u32x4*)(up + (long)dt * 2048) : (u32x4){0u, 0u, 0u, 0u}; }
    float s[8];
#pragma unroll
    for (int c = 0; c < 8; ++c) s[c] = 0.f;
#pragma unroll
    for (int i = 0; i < W; ++i)
#pragma unroll
        for (int c = 0; c < 4; ++c) { s[2 * c] += bflo(x[i][c]); s[2 * c + 1] += bfhi(x[i][c]); }
#pragma unroll
    for (int r = 0; r < 4; ++r) {
        const int cnt = (t0 + r + 1) < W ? (t0 + r + 1) : W; const float rc = 1.0f / (float)cnt;
        const u32x4 cur = x[W - 1 + r]; u32x4 o;
#pragma unroll
        for (int c = 0; c < 4; ++c) o[c] = cvtpk(s[2 * c] * rc - bflo(cur[c]), s[2 * c + 1] * rc - bfhi(cur[c]));
        st16(op + (size_t)r * 1024, o);
        if (r < 3) {
#pragma unroll
            for (int c = 0; c < 4; ++c) { s[2 * c] += bflo(x[W + r][c]) - bflo(x[r][c]); s[2 * c + 1] += bfhi(x[W + r][c]) - bfhi(x[r][c]); } }
    }
}
__device__ __forceinline__ void pool_unit(int b, int g, int xb, const bf16* Z, bf16* A2, int tid) {
    if (g == 0) pool_unit_w<2>(b, g, xb, Z, A2, tid); else if (g == 1) pool_unit_w<4>(b, g, xb, Z, A2, tid); else if (g == 2) pool_unit_w<8>(b, g, xb, Z, A2, tid); else pool_unit_w<16>(b, g, xb, Z, A2, tid);
}

__device__ __forceinline__ void moe_weight_items(Frame& F) {
    LAS float* scr = (LAS float*)(F.lds + RING_OFF + F.wave * 16384);
    const int gw = F.vcu * NWAVES + F.wave, NGW = F.G * NWAVES, lane = F.lane; unsigned char* ws = F.ws;
    for (int it0 = gw; it0 < 6144; it0 += 3 * NGW) {
        float v[3][32]; const float* W[3]; int ldw[3], k0[3], n0[3], ldt[3], drow[3]; bf16* WT[3]; const float* gain[3]; unsigned char* WT8[3];
#pragma unroll
        for (int j = 0; j < 3; ++j) { int r = it0 + j * NGW; if (r >= 6144) r = it0;
            if (r < 4096) { const int up = r >= 2048; if (up) r -= 2048; const int e = r >> 7, kb = (r >> 3) & 15, nb = r & 7; n0[j] = nb * 32; k0[j] = kb * 64;
                W[j] = F.in[up ? I_WU : I_WG] + (size_t)e * 1024 * 256; ldw[j] = 256; WT[j] = nullptr; ldt[j] = 1024; drow[j] = e * 512 + (n0[j] >> 7) * 256 + up * 128 + (n0[j] & 127); gain[j] = F.in[I_FNORM]; WT8[j] = ws + WS_WGUT8; }
            else { r -= 4096; const int e = r >> 7, kb = (r >> 5) & 3, nb = r & 31; n0[j] = nb * 32; k0[j] = kb * 64;
                W[j] = F.in[I_WD] + (size_t)e * 256 * 1024; ldw[j] = 1024; WT[j] = nullptr; ldt[j] = 256; drow[j] = n0[j]; gain[j] = nullptr; WT8[j] = ws + WS_WDT + (size_t)e * 1024 * 256; }
            p0_transpose_load(v[j], W[j], ldw[j], k0[j], n0[j], lane); }
#pragma unroll
        for (int j = 0; j < 3; ++j) if (it0 + j * NGW < 6144) p0_transpose_store(v[j], k0[j], WT[j], ldt[j], drow[j], k0[j], gain[j], scr, lane, WT8[j], 32.0f);
    }
}

__device__ __forceinline__ void p2_attention(Frame& F) {
    unsigned char* ws = F.ws; const bf16* Z = (const bf16*)(ws + WS_RB); bf16* A2 = (bf16*)(ws + WS_RA); const unsigned char* KT = ws + WS_RD;
    float lam; { const int l = F.lane; const float s1 = wave_sum(F.in[I_LQ1][l] * F.in[I_LK1][l]), s2 = wave_sum(F.in[I_LQ2][l] * F.in[I_LK2][l]); lam = __expf(s1) - __expf(s2) + 0.2f; }
    for (int p = F.vcu; p < 256; p += F.G) { const int bh = p >> 5, b = bh >> 2, h = bh & 3, s = p & 31;
#ifdef PROBE_ATT
        for (int j = 0; j < 4; ++j) { const int xb = (j & 1) ? s : 63 - s;
#else
        for (int j = 0; j < 2; ++j) { const int xb = j ? s : 63 - s;
#endif
            pool_unit(b, h, xb, Z, A2, F.tid);
#ifdef PROBE_POOL
            pool_unit(b, h, xb, Z, A2, F.tid);
#endif
#ifdef PROBE_ATTMODE
            dat::attn_unit<8, PROBE_ATTMODE>(b, h, xb, Z, KT, (bf16*)(F.ws + WS_RC), F.in[I_RELB], F.in[I_SUBLN], lam, (LAS char*)(F.lds + RING_OFF));
#endif
            dat::attn_unit<8>(b, h, xb, Z, KT, A2, F.in[I_RELB], F.in[I_SUBLN], lam, (LAS char*)(F.lds + RING_OFF));
            } }
    struct FoldJobs { const bf16* KVc; unsigned char* ws; int vcu, G;
        __device__ __forceinline__ TileJob operator()(int i) const { const int tI = vcu + i * G, t2 = tI & 511, bh = t2 >> 6, b = bh >> 2, hh = bh & 3, w = t2 & 63; TileJob j;
            if (tI < 512) { const int kt = w >> 4, kkt = w & 15;
                j.A = KVc + (size_t)(b * 256 + kt * 64) * 2048 + hh * 256; j.lda = 2048; j.B = (const bf16*)(ws + WS_WQN) + (size_t)(kkt * 64) * 1024 + hh * 256; j.ldb = 1024;
                j.C = (bf16*)(ws + WS_BTS + (size_t)b * 1024 * 1024 + (size_t)(hh * 256 + kt * 64) * 1024 + kkt * 64); j.ldc = 1024; j.c8 = 1; }
            else { const int nt = w >> 2, kt = w & 3;
                j.A = (const bf16*)(ws + WS_WOT) + (size_t)(nt * 64) * 1024 + hh * 256; j.lda = 1024; j.B = KVc + (size_t)(b * 256 + kt * 64) * 2048 + 1024 + hh * 256; j.ldb = 2048;
                j.C = (bf16*)(ws + WS_BTO + (size_t)b * 1024 * 1024 + (size_t)(nt * 64) * 1024 + hh * 256 + kt * 64); j.ldc = 1024; j.c8 = 1; }
            return j; } };
    const PlainJobs<FoldJobs> fj{FoldJobs{(const bf16*)(ws + WS_KVC), ws, F.vcu, F.G}};
    tile_pipe<256, 1>((LAS char*)(F.lds + RING_OFF), (1024 - F.vcu + F.G - 1) / F.G, fj, F.wave, F.lane);
    moe_weight_items(F);
}

struct RouteJobs { const bf16* H2; const bf16* WR; LAS float* lg; int chunk;
    __device__ __forceinline__ const bf16* arow(int, int row) const { return H2 + (size_t)(chunk * 64 + row) * 1024; }
    __device__ __forceinline__ const bf16* brow(int, int row) const { return WR + (size_t)(row & 31) * 1024; }
    __device__ __forceinline__ void store(int, int wave, int lane, f32x4 acc0, f32x4 acc1) const {
        if ((wave >> 2) == 0) { LAS float* p = lg + (16 * (wave & 3) + (lane & 15)) * 33 + 4 * (lane >> 4);
#pragma unroll
            for (int j = 0; j < 4; ++j) { p[j] = acc0[j]; p[16 + j] = acc1[j]; } } }
};
__device__ __forceinline__ void p6_route(Frame& F) {
    unsigned char* ws = F.ws; const float* SSQ2 = (const float*)(ws + WS_SSQ2);
    LAS int* lcnt = (LAS int*)(F.lds + LTAB_OFF); LAS int* gbase = lcnt + 16; LAS float* lg = (LAS float*)(F.lds + LTAB_OFF + 1024);
    if (F.tid < 16) lcnt[F.tid] = 0;
    for (int chunk = F.vcu; chunk < M / 64; chunk += F.G) {
        const RouteJobs rj{(const bf16*)(ws + WS_RA), (const bf16*)(ws + WS_WR), lg, chunk};
        tile_pipe<256, 4>((LAS char*)(F.lds + RING_OFF), 1, rj, F.wave, F.lane);
        bool emit = false; int e0 = 0, e1 = 0, p0 = 0, p1 = 0; const int tok = chunk * 64 + F.tid; float w0 = 0.f, w1 = 0.f, rs = 0.f;
        if (F.tid < 64) {
            { const f32x4* sp = (const f32x4*)(SSQ2 + (size_t)tok * 16); const f32x4 st = (sp[0] + sp[1]) + (sp[2] + sp[3]); rs = 1.0f / __builtin_sqrtf(((st[0] + st[1]) + (st[2] + st[3])) * (1.0f / 1024.0f) + EPS); }
            const LAS float* l = lg + F.tid * 33;
            float gl[4];
#pragma unroll
            for (int j = 0; j < 4; ++j) gl[j] = l[16 + j] * rs + F.in[I_RGB][j];
            int gs = 0; float gm = gl[0];
#pragma unroll
            for (int j = 1; j < 4; ++j) if (gl[j] > gm) { gm = gl[j]; gs = j; }
            float den = 0.f;
#pragma unroll
            for (int j = 0; j < 4; ++j) den += __expf(gl[j] - gm);
            const float gwt = 1.0f / den;
            float el[4];
#pragma unroll
            for (int j = 0; j < 4; ++j) el[j] = l[gs * 4 + j] * rs + F.in[I_REB][gs * 4 + j];
            int i0 = 0; float v0 = el[0];
#pragma unroll
            for (int j = 1; j < 4; ++j) if (el[j] > v0) { v0 = el[j]; i0 = j; }
            int i1 = -1; float v1 = -3.0e38f;
#pragma unroll
            for (int j = 0; j < 4; ++j) if (j != i0 && el[j] > v1) { v1 = el[j]; i1 = j; }
            const float t0 = 1.0f / (1.0f + __expf(v1 - v0));
            emit = true; e0 = gs * 4 + i0; e1 = gs * 4 + i1; w0 = gwt * t0; w1 = gwt * (1.0f - t0);
            p0 = atomicAdd((int*)(lcnt + e0), 1); p1 = atomicAdd((int*)(lcnt + e1), 1);
        }
        __syncthreads();
        if (F.tid < 16) gbase[F.tid] = (int)__hip_atomic_fetch_add(F.ctl + CW_CNT + 64 * F.tid, (unsigned)lcnt[F.tid], RLX_AGENT);
        __syncthreads();
        if (emit) { int* LIST = (int*)(ws + WS_LIST); float* LR = (float*)(ws + WS_LISTR); float* LW = (float*)(ws + WS_LISTW);
            const int i0 = e0 * 16384 + gbase[e0] + p0, i1 = e1 * 16384 + gbase[e1] + p1;
            LIST[i0] = tok * 2; LR[i0] = rs; LW[i0] = w0; LIST[i1] = tok * 2 + 1; LR[i1] = rs; LW[i1] = w1; }
        __syncthreads();
        if (F.tid < 16) lcnt[F.tid] = 0;
    }
}

__device__ __forceinline__ int moe_table(Frame& F) {
    LAS int* tab = (LAS int*)(F.lds + LTAB_OFF);
    __syncthreads();
    if (F.tid < 16) tab[32 + F.tid] = (int)__hip_atomic_load(F.ctl + CW_CNT + 64 * F.tid, RLX_AGENT);
    __syncthreads();
    if (F.tid == 0) { int p = 0, pf = 0, pt = 0; for (int e = 0; e < 16; ++e) { const int n = tab[32 + e]; tab[e] = p; tab[64 + e] = pf; tab[96 + e] = pt; p += (n + 255) >> 8; pf += n >> 8; pt += ((n & 255) + 63) >> 6; } tab[16] = p; tab[80] = pf; tab[112] = pt; }
    __syncthreads();
    return __builtin_amdgcn_readfirstlane(tab[80]);
}
struct TailBase { LAS const int* tab; int vcu, G, CT;
    __device__ __forceinline__ void decode(int i, int& e, int& r0, int& nv, int& ct) const {
        const int J = vcu + i * G, trow = J / CT; ct = J % CT; int ee = 0;
#pragma unroll
        for (int j = 1; j < 16; ++j) ee += (trow >= tab[96 + j]) ? 1 : 0;
        ee = __builtin_amdgcn_readfirstlane(ee); e = ee;
        const int n = __builtin_amdgcn_readfirstlane(tab[32 + ee]), ptt = __builtin_amdgcn_readfirstlane(tab[96 + ee]);
        r0 = (n >> 8) * 256 + (trow - ptt) * 64; nv = n - r0 < 64 ? n - r0 : 64;
    }
};
struct TailGateUp { TailBase tb; const bf16* H2b; const bf16* WguT; const int* list; const float* listr; const float* listw; unsigned char* ACT; float ascale;
    __device__ __forceinline__ const bf16* arow(int i, int lane) const { int e, r0, nv, ct; tb.decode(i, e, r0, nv, ct); const int tok = lane < nv ? (list[e * 16384 + r0 + lane] >> 1) : 0; return H2b + (size_t)tok * 512; }
    __device__ __forceinline__ const bf16* brow(int i, int lane) const { int e, r0, nv, ct; tb.decode(i, e, r0, nv, ct); const int c = ct * 32 + (lane >> 5) * 16 + (lane & 15), up = (lane >> 4) & 1;
        return WguT + (size_t)(e * 512 + (c >> 7) * 256 + up * 128 + (c & 127)) * 512; }
    __device__ __forceinline__ void store(int i, int wave, int lane, f32x4 acc0, f32x4 acc1) const { int e, r0, nv, ct; tb.decode(i, e, r0, nv, ct);
        const int row = 16 * (wave & 3) + (lane & 15); const bool ok = row < nv; const int li = e * 16384 + r0 + row;
        const float rs = ok ? listr[li] * ascale : 0.f, cw = ok ? listw[li] * 8.0f : 0.f; float a[4];
#pragma unroll
        for (int j = 0; j < 4; ++j) { const float g = acc0[j] * rs, up = acc1[j] * rs; a[j] = __builtin_amdgcn_fmed3f(g * __builtin_amdgcn_rcpf(1.0f + __builtin_amdgcn_exp2f(-g * LOG2E)) * up * cw, -448.0f, 448.0f); }
        *(GAS unsigned*)(ACT + (size_t)(tb.tab[e] * 256 + r0 + row) * 256 + ct * 32 + (wave >> 2) * 16 + 4 * (lane >> 4)) = pk4_fp8(a[0], a[1], a[2], a[3]); }
};
struct TailDown { TailBase tb; const bf16* ACT; const bf16* WdT; const int* list; unsigned char* YS; float ascale;
    __device__ __forceinline__ const bf16* arow(int i, int lane) const { int e, r0, nv, ct; tb.decode(i, e, r0, nv, ct); return ACT + (size_t)(tb.tab[e] * 256 + r0 + lane) * 128; }
    __device__ __forceinline__ const bf16* brow(int i, int lane) const { int e, r0, nv, ct; tb.decode(i, e, r0, nv, ct); return WdT + (size_t)e * 1024 * 128 + (size_t)(ct * 64 + lane) * 128; }
    __device__ __forceinline__ void store(int i, int wave, int lane, f32x4 acc0, f32x4 acc1) const { int e, r0, nv, ct; tb.decode(i, e, r0, nv, ct);
        const int row = 16 * (wave & 3) + (lane & 15);
        if (row < nv) { const unsigned v = (unsigned)list[e * 16384 + r0 + row]; unsigned char* cp = YS + ((size_t)(((v & 1u) << 14) + (v >> 1)) << 10) + ct * 64 + 32 * (wave >> 2) + 4 * (lane >> 4);
            acc0 *= ascale; acc1 *= ascale;
            *(GAS unsigned*)cp = pk4_fp8(__builtin_amdgcn_fmed3f(acc0[0], -448.f, 448.f), __builtin_amdgcn_fmed3f(acc0[1], -448.f, 448.f), __builtin_amdgcn_fmed3f(acc0[2], -448.f, 448.f), __builtin_amdgcn_fmed3f(acc0[3], -448.f, 448.f));
            *(GAS unsigned*)(cp + 16) = pk4_fp8(__builtin_amdgcn_fmed3f(acc1[0], -448.f, 448.f), __builtin_amdgcn_fmed3f(acc1[1], -448.f, 448.f), __builtin_amdgcn_fmed3f(acc1[2], -448.f, 448.f), __builtin_amdgcn_fmed3f(acc1[3], -448.f, 448.f)); } }
};

__device__ __forceinline__ void p9_final(Frame& F) {
    const int gw = F.vcu * NWAVES + F.wave, NGW = F.G * NWAVES, lane = F.lane; const unsigned char* YS = F.ws + WS_RB; const bf16* H2 = (const bf16*)(F.ws + WS_RA);
    const GAS f32x4* gr = (const GAS f32x4*)F.in[I_FINAL] + lane;
    for (int m0 = 2 * gw; m0 < M; m0 += 2 * NGW) {
        f32x4 v[2][4]; u32x2 hb[2][4]; unsigned a[2][4], c[2][4]; float s[2];
#pragma unroll
        for (int r = 0; r < 2; ++r) { const int m = m0 + r; const GAS u32x2* xr = (const GAS u32x2*)(H2 + (size_t)m * D) + lane;
            const GAS unsigned* y0 = (const GAS unsigned*)(YS + (size_t)m * D) + lane; const GAS unsigned* y1 = (const GAS unsigned*)(YS + ((size_t)M + m) * D) + lane;
#pragma unroll
            for (int j = 0; j < 4; ++j) { hb[r][j] = xr[64 * j]; a[r][j] = y0[64 * j]; c[r][j] = y1[64 * j]; } }
#pragma unroll
        for (int r = 0; r < 2; ++r) { s[r] = 0.f;
#pragma unroll
            for (int j = 0; j < 4; ++j) { const auto a01 = __builtin_amdgcn_cvt_pk_f32_fp8((int)a[r][j], false), a23 = __builtin_amdgcn_cvt_pk_f32_fp8((int)a[r][j], true), c01 = __builtin_amdgcn_cvt_pk_f32_fp8((int)c[r][j], false), c23 = __builtin_amdgcn_cvt_pk_f32_fp8((int)c[r][j], true);
                v[r][j].x = bflo(hb[r][j].x) + (a01[0] + c01[0]) * 0.0625f; v[r][j].y = bfhi(hb[r][j].x) + (a01[1] + c01[1]) * 0.0625f;
                v[r][j].z = bflo(hb[r][j].y) + (a23[0] + c23[0]) * 0.0625f; v[r][j].w = bfhi(hb[r][j].y) + (a23[1] + c23[1]) * 0.0625f;
                s[r] += (v[r][j].x * v[r][j].x + v[r][j].y * v[r][j].y) + (v[r][j].z * v[r][j].z + v[r][j].w * v[r][j].w); } }
#pragma unroll
        for (int r = 0; r < 2; ++r) { const float rstd = 1.f / __builtin_sqrtf(wave_sum(s[r]) * (1.f / D) + EPS); GAS f32x4* xo = (GAS f32x4*)(F.out + (size_t)(m0 + r) * D) + lane;
#pragma unroll
            for (int j = 0; j < 4; ++j) { const f32x4 g = gr[64 * j]; __builtin_nontemporal_store(v[r][j] * rstd * g, xo + 64 * j); } }
    }
}
struct Args { const float* in[27]; float* out; unsigned char* ws; int ph_lo, ph_hi, li, pad; };
__global__ void __launch_bounds__(NWAVES * 64, 2) hybrid_fwd(Args args) {
    extern __shared__ __attribute__((aligned(16))) unsigned char lds[];
    Frame F;
    F.lds = (LAS unsigned char*)lds;
    F.MISC = (volatile LAS unsigned*)(F.lds + MISC_OFF);
    F.tid = threadIdx.x; F.lane = F.tid & 63; F.wave = __builtin_amdgcn_readfirstlane(F.tid >> 6);
    F.G = gridDim.x; { const int bx = blockIdx.x; F.vcu = (F.G % 8 == 0) ? (bx % 8) * (F.G / 8) + bx / 8 : bx; }
    unsigned char* ws = args.ws; F.ws = ws; F.out = args.out;
#pragma unroll
    for (int i = 0; i < 27; ++i) F.in[i] = args.in[i];
    F.ctl = (gu32*)(ws + WS_CTL);
    for (int u = F.tid; u < (LDS_BYTES - LDSCTL_OFF) / 4; u += NWAVES * 64) ((LAS unsigned*)(F.lds + LDSCTL_OFF))[u] = 0u;
    __syncthreads();
    XcdBarrier bar = xcd_barrier_post((unsigned*)(F.ctl + CW_BAR) + args.li * XCD_BAR_WORDS, F.MISC + 8);
    if (threadIdx.x == 0) __hip_atomic_store((unsigned*)(F.ctl + CW_XCC) + F.vcu, 1u + bar.x, RLX_AGENT);
    const int lo = args.ph_lo, hi = args.ph_hi;
#ifndef PH_MASK
#define PH_MASK 0x3ff
#endif
#define IN(k) ((((PH_MASK) >> (k)) & 1) && lo <= (k) && (k) < hi)
#define BOTH(k) (IN(k) && IN((k) + 1))
#ifndef PROBE_MASK
#define PROBE_MASK 0
#endif
#define REP(k) (((PROBE_MASK) >> (k)) & 1)
#define GRID_BAR() xcd_barrier(bar)

    if (IN(0)) { p0_prologue(F); if (REP(0)) { GRID_BAR(); p0_prologue(F); } if (BOTH(0)) GRID_BAR(); }

    if (IN(1)) {
        {
            struct KvJobs { unsigned char* ws; int vcu, G;
                __device__ __forceinline__ TileJob operator()(int i) const { const int tI = vcu + i * G, rt = tI >> 5, ct = tI & 31; TileJob j;
                    j.A = (const bf16*)(ws + WS_MN) + (size_t)(rt * 64) * 1024; j.lda = 1024; j.B = (const bf16*)(ws + WS_WKVT) + (size_t)(ct * 64) * 1024; j.ldb = 1024;
                    j.C = (bf16*)(ws + WS_KVC) + (size_t)(rt * 64) * 2048 + ct * 64; j.ldc = 2048; j.c8 = 0; return j; } };
            const PlainJobs<KvJobs> kj{KvJobs{ws, F.vcu, F.G}};
            tile_pipe<256, 4>((LAS char*)(F.lds + RING_OFF), (256 - F.vcu + F.G - 1) / F.G, kj, F.wave, F.lane);
            struct PfJobs { unsigned char* ws; int vcu, G;
                __device__ __forceinline__ TileJob operator()(int i) const { const int tI = vcu + i * G, g = tI >> 5, nt = (tI >> 1) & 15, ct = tI & 1; TileJob j;
                    j.A = (const bf16*)(ws + WS_WTMP) + (size_t)(nt * 64) * 512 + g * 128; j.lda = 512; j.B = (const bf16*)(ws + WS_PWS) + (size_t)(g * 128 + ct * 64) * 128; j.ldb = 128;
                    j.C = (bf16*)(ws + WS_WOUTT) + (size_t)(nt * 64) * 1024 + 512 + g * 128 + ct * 64; j.ldc = 1024; j.c8 = 0; return j; } };
            const PlainJobs<PfJobs> pj{PfJobs{ws, F.vcu, F.G}};
            tile_pipe<128, 1>((LAS char*)(F.lds + RING_OFF), F.vcu < 128 ? (128 - F.vcu + F.G - 1) / F.G : 0, pj, F.wave, F.lane);
        }
        pg8::DenseOrder S; S.init(ws + WS_XB, ws + WS_WINT, M, 2048, D, 0, F.G, (int)blockIdx.x);
        pg8::EpiZ E{(bf16*)(ws + WS_RB), ws + WS_RD, C2, (const float*)(ws + WS_RSX), F.lds + 131072};
        pg8::gemm_phase<pg8::EpiZ, pg8::DenseOrder, true>(F.lds + RING_OFF, D, S, E); if (REP(1)) { GRID_BAR(); pg8::gemm_phase<pg8::EpiZ, pg8::DenseOrder, true>(F.lds + RING_OFF, D, S, E); }
        if (BOTH(1)) GRID_BAR();
    }

    if (IN(2)) { p2_attention(F);
        if (REP(2)) { GRID_BAR(); p2_attention(F); }
        if (BOTH(2)) GRID_BAR(); }

    const bool panel = (PROBE_MASK) == 0 && F.G == 256 && BOTH(3) && BOTH(4) && BOTH(5);
    unsigned* const pcnt = (unsigned*)(F.ctl + CW_PAN); unsigned* const ptmo = (unsigned*)(F.ctl + CW_BAR) + args.li * XCD_BAR_WORDS + XB_TMO;
    int mypm = 0; bool plocal = false;
    if (panel) { pg8::DenseOrder S0; S0.init(ws, ws, M, D, D, 0, F.G, (int)blockIdx.x); pg8::Unit u0; S0.next(0, u0); mypm = u0.pm;
        unsigned same = 1u; const unsigned me = 1u + bar.x;
#pragma unroll
        for (int j = 0; j < 4; ++j) { same &= (xb_ld((unsigned*)(F.ctl + CW_XCC) + 32 * (mypm >> 3) + 8 * j + (mypm & 7)) == me) ? 1u : 0u; same &= (xb_ld((unsigned*)(F.ctl + CW_XCC) + 4 * mypm + j) == me) ? 1u : 0u; }
        plocal = __builtin_amdgcn_readfirstlane((int)same) != 0; }

    if (IN(3)) {
        pg8::DenseOrder S; S.init(ws + WS_RA, ws + WS_WOUTT, M, D, D, 0, F.G, (int)blockIdx.x);
        pg8::EpiRes<true, true> E{(const bf16*)(ws + WS_XB), (bf16*)(ws + WS_RC), (float*)(ws + WS_SSQ1), ws + WS_RD + 16 * MiB, 1.0f};
        pg8::gemm_phase<pg8::EpiRes<true, true>, pg8::DenseOrder, true>(F.lds + RING_OFF, D, S, E); if (REP(3)) { GRID_BAR(); pg8::gemm_phase<pg8::EpiRes<true, true>, pg8::DenseOrder, true>(F.lds + RING_OFF, D, S, E); }
        if (panel) { panel_signal(pcnt + (0 * 64 + mypm) * 16, plocal); panel_wait(pcnt + (0 * 64 + mypm) * 16, 4u, ptmo); } else if (BOTH(3)) GRID_BAR();
    }

    if (IN(4)) {
        pg8::DenseOrder S; S.init(ws + WS_RD + 16 * MiB, ws + WS_BTS, M, D, D / 2, (size_t)1024 * 1024, F.G, (int)blockIdx.x);
        pg8::EpiSoftmax E{(const float*)(ws + WS_SSQ1), ws + WS_RD};
        pg8::gemm_phase<pg8::EpiSoftmax, pg8::DenseOrder, false, true>(F.lds + RING_OFF, D / 2, S, E); if (REP(4)) { GRID_BAR(); pg8::gemm_phase<pg8::EpiSoftmax, pg8::DenseOrder, false, true>(F.lds + RING_OFF, D / 2, S, E); }
        if (panel) { panel_signal(pcnt + (1 * 64 + mypm) * 16, plocal); panel_wait(pcnt + (1 * 64 + mypm) * 16, 4u, ptmo); } else if (BOTH(4)) GRID_BAR();
    }

    if (IN(5)) {
        pg8::DenseOrder S; S.init(ws + WS_RD, ws + WS_BTO, M, D, D / 2, (size_t)1024 * 1024, F.G, (int)blockIdx.x);
        pg8::EpiRes<true, true> E{(const bf16*)(ws + WS_RC), (bf16*)(ws + WS_RA), (float*)(ws + WS_SSQ2), ws + WS_RD + 16 * MiB, 1.0f / 256.0f};
        pg8::gemm_phase<pg8::EpiRes<true, true>, pg8::DenseOrder, true, true>(F.lds + RING_OFF, D / 2, S, E); if (REP(5)) { GRID_BAR(); pg8::gemm_phase<pg8::EpiRes<true, true>, pg8::DenseOrder, true, true>(F.lds + RING_OFF, D / 2, S, E); }
        if (panel) { panel_signal(pcnt + (2 * 64 + mypm) * 16, plocal); panel_wait(pcnt + (2 * 64 + (F.vcu >> 2)) * 16, 4u, ptmo); } else if (BOTH(5)) GRID_BAR();
    }

    if (IN(6)) { p6_route(F); if (BOTH(6)) GRID_BAR(); }

    if (IN(7)) {
        const int nft = moe_table(F); LAS const int* tab = (LAS const int*)(F.lds + LTAB_OFF);
        { const int ntt = __builtin_amdgcn_readfirstlane(tab[112]) * 8;
          const TailGateUp tj{TailBase{tab, F.vcu, F.G, 8}, (const bf16*)(ws + WS_RD + 16 * MiB), (const bf16*)(ws + WS_WGUT8), (const int*)(ws + WS_LIST), (const float*)(ws + WS_LISTR), (const float*)(ws + WS_LISTW), ws + WS_RC, 1.0f / 32.0f};
          tile_pipe<256, 2, true>((LAS char*)(F.lds + RING_OFF), F.vcu < ntt ? (ntt - F.vcu + F.G - 1) / F.G : 0, tj, F.wave, F.lane); }
        pg8::MoeOrder<2, true> S{tab, (const char*)(ws + WS_RD + 16 * MiB), (const char*)(ws + WS_WGUT8), (const int*)(ws + WS_LIST), F.G, F.vcu, nft * 2, (size_t)512 * 1024, (size_t)256 * 1024};
        pg8::EpiGateUp E{ws + WS_RC, (const float*)(ws + WS_LISTR), (const float*)(ws + WS_LISTW), 1.0f / 32.0f};
        pg8::gemm_phase<pg8::EpiGateUp, pg8::MoeOrder<2, true>, true, true>(F.lds + RING_OFF, D / 2, S, E);
        if (REP(7)) { GRID_BAR(); pg8::gemm_phase<pg8::EpiGateUp, pg8::MoeOrder<2, true>, true, true>(F.lds + RING_OFF, D / 2, S, E); }
        if (REP(10)) { GRID_BAR(); const int ntt = __builtin_amdgcn_readfirstlane(tab[112]) * 8;
          const TailGateUp tj{TailBase{tab, F.vcu, F.G, 8}, (const bf16*)(ws + WS_RD + 16 * MiB), (const bf16*)(ws + WS_WGUT8), (const int*)(ws + WS_LIST), (const float*)(ws + WS_LISTR), (const float*)(ws + WS_LISTW), ws + WS_RC, 1.0f / 32.0f};
          tile_pipe<256, 2, true>((LAS char*)(F.lds + RING_OFF), F.vcu < ntt ? (ntt - F.vcu + F.G - 1) / F.G : 0, tj, F.wave, F.lane); }
        if (BOTH(7)) GRID_BAR();
    }

    if (IN(8)) {
        LAS const int* tab = (LAS const int*)(F.lds + LTAB_OFF);
        const int nft = IN(7) ? __builtin_amdgcn_readfirstlane(tab[80]) : moe_table(F);
        { const int ntt = __builtin_amdgcn_readfirstlane(tab[112]) * 16;
          const TailDown tj{TailBase{tab, F.vcu, F.G, 16}, (const bf16*)(ws + WS_RC), (const bf16*)(ws + WS_WDT), (const int*)(ws + WS_LIST), ws + WS_RB, 1.0f / 16.0f};
          tile_pipe<128, 1, true>((LAS char*)(F.lds + RING_OFF), F.vcu < ntt ? (ntt - F.vcu + F.G - 1) / F.G : 0, tj, F.wave, F.lane); }
        pg8::MoeOrder<4, false> S{tab, (const char*)(ws + WS_RC), (const char*)(ws + WS_WDT), (const int*)(ws + WS_LIST), F.G, F.vcu, nft * 4, (size_t)1024 * 256, (size_t)256 * 256, (size_t)FF};
        pg8::EpiDown E{ws + WS_RB, (const int*)(ws + WS_LIST), 1.0f / 16.0f};
        pg8::gemm_phase<pg8::EpiDown, pg8::MoeOrder<4, false>, true, true>(F.lds + RING_OFF, FF / 2, S, E);
        if (REP(8)) { GRID_BAR(); pg8::gemm_phase<pg8::EpiDown, pg8::MoeOrder<4, false>, true, true>(F.lds + RING_OFF, FF / 2, S, E); }
        if (BOTH(8)) GRID_BAR();
    }

    if (IN(9)) { p9_final(F); if (REP(9)) { GRID_BAR(); p9_final(F); } }
#undef IN
#undef BOTH
#undef GRID_BAR
}

extern "C" void kernel_launch(void* const* d_in, const int* in_sizes, int n_in, void* d_out, int out_size, void* d_ws, size_t ws_size, hipStream_t stream) {
    static int grid = 0;
    if (grid == 0) {
        if (n_in != 27 || in_sizes[0] != M * D || out_size != M * D || ws_size < WS_END) { fprintf(stderr, "kernel_launch: unexpected problem shape (n_in %d, in0 %d, out %d, ws %zu); nothing launched\n", n_in, n_in > 0 ? in_sizes[0] : -1, out_size, ws_size); grid = -1; return; }
        int dev = 0, cus = 0, per_cu = 0;
        if (hipGetDevice(&dev) != hipSuccess || hipDeviceGetAttribute(&cus, hipDeviceAttributeMultiprocessorCount, dev) != hipSuccess) { grid = -1; return; }
        if (hipFuncSetAttribute((const void*)hybrid_fwd, hipFuncAttributeMaxDynamicSharedMemorySize, LDS_BYTES) != hipSuccess) { fprintf(stderr, "kernel_launch: hipFuncSetAttribute failed\n"); grid = -1; return; }
        if (hipOccupancyMaxActiveBlocksPerMultiprocessor(&per_cu, (const void*)hybrid_fwd, NWAVES * 64, LDS_BYTES) != hipSuccess || per_cu < 1) { fprintf(stderr, "kernel_launch: occupancy query reports %d workgroups per CU\n", per_cu); }
        (void)hipGetLastError();
        grid = cus < 256 ? cus : 256;
        if (grid != 256) fprintf(stderr, "kernel_launch: %d CUs: the single-unit GEMM phases assume 256 workgroups\n", grid);
    }
    if (grid < 0) return;
    if (hipMemsetAsync((char*)d_ws + WS_CTL, 0, CTL_ZERO_BYTES, stream) != hipSuccess) return;
    Args a{};
    for (int i = 0; i < 27; ++i) a.in[i] = (const float*)d_in[i];
    a.out = (float*)d_out; a.ws = (unsigned char*)d_ws; a.pad = 0;
    constexpr int NL = MK_N_LAUNCHES;
    for (int li = 0; li < NL; ++li) {
        a.ph_lo = (NL == 1) ? 0 : li; a.ph_hi = (NL == 1) ? N_PHASES : li + 1; a.li = li;
        hipLaunchKernelGGL(hybrid_fwd, dim3(grid), dim3(NWAVES * 64), LDS_BYTES, stream, a);
    }
}
```

```cpp
#include <hip/hip_runtime.h>
#include <cstdio>
#include <cstdint>

#define GAS __attribute__((address_space(1)))
#define LAS __attribute__((address_space(3)))
typedef unsigned short bf16;
typedef short bf16x8 __attribute__((ext_vector_type(8)));
typedef float f32x4 __attribute__((ext_vector_type(4)));
typedef float f32x2 __attribute__((ext_vector_type(2)));
typedef float f32x16 __attribute__((ext_vector_type(16)));
typedef unsigned u32x4 __attribute__((ext_vector_type(4)));
typedef unsigned u32x2 __attribute__((ext_vector_type(2)));
typedef __bf16 bf16x2_t __attribute__((ext_vector_type(2)));

__device__ __forceinline__ unsigned cvtpk(float lo, float hi) { f32x2 v = {lo, hi}; bf16x2_t b = __builtin_convertvector(v, bf16x2_t); return __builtin_bit_cast(unsigned, b); }
__device__ __forceinline__ float bf2f(unsigned short b) { return __builtin_bit_cast(float, (unsigned)b << 16); }
__device__ __forceinline__ float bflo(unsigned w) { return __builtin_bit_cast(float, w << 16); }
__device__ __forceinline__ float bfhi(unsigned w) { return __builtin_bit_cast(float, w & 0xffff0000u); }

__device__ __forceinline__ unsigned pk4_fp8(float a, float b, float c, float d) { int w = 0; w = __builtin_amdgcn_cvt_pk_fp8_f32(a, b, w, false); w = __builtin_amdgcn_cvt_pk_fp8_f32(c, d, w, true); return (unsigned)w; }
typedef int v8i32 __attribute__((ext_vector_type(8))); typedef int v4i32 __attribute__((ext_vector_type(4)));

#ifndef WT_STORES
#define WT_STORES 0
#endif
__device__ __forceinline__ void st16(void* p, u32x4 v) {
#if WT_STORES
    asm volatile("global_store_dwordx4 %0, %1, off sc1\n\ts_nop 1" :: "v"(p), "v"(v) : "memory");
#else
    *(u32x4*)p = v;
#endif
}
__device__ __forceinline__ void st8(void* p, u32x2 v) {
#if WT_STORES
    asm volatile("global_store_dwordx2 %0, %1, off sc1\n\ts_nop 1" :: "v"(p), "v"(v) : "memory");
#else
    *(u32x2*)p = v;
#endif
}

namespace pg8 {
constexpr int BM = 256, BK = 64, HALF = 128, HTB = HALF * BK * 2  , STAGE_BYTES = 8 * HTB, NXCD = 8, WGM = 8;

__host__ __device__ __forceinline__ int lds_byte(int r, int c) { const int st = (r >> 4) * 2 + (c >> 5), rr = r & 15, cc = c & 31, ob = rr * 64 + cc * 2; return st * 1024 + (ob ^ (((ob >> 9) & 1) << 5)); }
__host__ __device__ __forceinline__ void stage_rc(int b, int& R, int& C) { const int st = b / 1024, sb = b % 1024, swz = sb ^ (((sb >> 9) & 1) << 5); R = (st >> 1) * 16 + swz / 64; C = (st & 1) * 32 + (swz % 64) / 2; }
__host__ __device__ __forceinline__ int perm32(int rho) { const int n = rho >> 4, i = rho & 15; return 8 * (i >> 2) + 4 * n + (i & 3); }

struct Unit { int pm, pn, e, row0, nval, lofs; };

template <class Epi, class Sched, bool ALIGN_EPI, bool F8 = false>
__device__ __forceinline__ void gemm_phase(LAS unsigned char* lds, const int K, const Sched& S, const Epi& E) {
    const int tid = threadIdx.x, wid = __builtin_amdgcn_readfirstlane(tid >> 6), lane = tid & 63, wr = wid >> 2, wc = wid & 3, fr = lane & 15, fq = lane >> 4;
    const int nt = K / BK;
    int Rl[2], Cl[2];
    unsigned voffA[2][2], voffAn[2][2], voffB[2][2];
#pragma unroll
    for (int i = 0; i < 2; ++i) { int R, C; stage_rc(tid * 16 + i * 8192, R, C); Rl[i] = R; Cl[i] = C; const int Rb = Epi::PERM ? ((R & ~31) + perm32(R & 31)) : R;
#pragma unroll
        for (int h = 0; h < 2; ++h) { voffB[h][i] = (unsigned)((Rb + HALF * h) * K + C) * 2u; voffA[h][i] = (unsigned)((R + HALF * h) * K + C) * 2u; voffAn[h][i] = voffA[h][i]; } }
    const size_t kstep = (size_t)(BK * 2);
    const unsigned ldsw = (unsigned)wid * 1024u;
    const int aoff = lds_byte(wr * 64 + fr, fq * 8), boff = lds_byte(wc * 32 + fr, fq * 8);
#define PG8_SA(b, h) (((b) * 2 + (h)) * HTB)
#define PG8_SB(b, h) ((4 + (b) * 2 + (h)) * HTB)
#define PG8_STAGE(bufoff, gbase, voff) do { _Pragma("unroll") for (int _i = 0; _i < 2; ++_i) \
        __builtin_amdgcn_global_load_lds((const unsigned*)((const char*)(gbase) + (voff)[_i]), (LAS unsigned*)(lds + (bufoff) + ldsw + _i * 8192), 16, 0, 0); } while (0)
#define PG8_LDA(dst, b, h) do { _Pragma("unroll") for (int m = 0; m < 4; ++m) { dst[m].lo = *(const LAS v4i32*)(lds + PG8_SA(b, h) + aoff + m * 2048); dst[m].hi = *(const LAS v4i32*)(lds + PG8_SA(b, h) + aoff + m * 2048 + 1024); } } while (0)
#define PG8_LDB(dst, b, h) do { _Pragma("unroll") for (int n = 0; n < 2; ++n) { dst[n].lo = *(const LAS v4i32*)(lds + PG8_SB(b, h) + boff + n * 2048); dst[n].hi = *(const LAS v4i32*)(lds + PG8_SB(b, h) + boff + n * 2048 + 1024); } } while (0)
#define PG8_CAT(x) __builtin_shufflevector((x).lo, (x).hi, 0, 1, 2, 3, 4, 5, 6, 7)
#define PG8_MMA(ai, bj, At, Bt) do { __builtin_amdgcn_s_setprio(1); _Pragma("unroll") for (int m = 0; m < 4; ++m) _Pragma("unroll") for (int n = 0; n < 2; ++n) { \
        if constexpr (F8) { const v8i32 b8_ = PG8_CAT(Bt[n]), a8_ = PG8_CAT(At[m]); asm volatile("v_mfma_f32_16x16x128_f8f6f4 %0, %1, %2, %0" : "+v"(acc[ai][bj][m][n]) : "v"(b8_), "v"(a8_)); } \
        else { acc[ai][bj][m][n] = __builtin_amdgcn_mfma_f32_16x16x32_bf16(__builtin_bit_cast(bf16x8, Bt[n].lo), __builtin_bit_cast(bf16x8, At[m].lo), acc[ai][bj][m][n], 0, 0, 0); \
               acc[ai][bj][m][n] = __builtin_amdgcn_mfma_f32_16x16x32_bf16(__builtin_bit_cast(bf16x8, Bt[n].hi), __builtin_bit_cast(bf16x8, At[m].hi), acc[ai][bj][m][n], 0, 0, 0); } } \
        __builtin_amdgcn_s_setprio(0); } while (0)
#define PG8_WAIT_V(n) asm volatile("s_waitcnt vmcnt(" #n ")" ::: "memory")
#define PG8_WAIT_L(n) asm volatile("s_waitcnt lgkmcnt(" #n ")" ::: "memory")
#define PG8_BAR __builtin_amdgcn_s_barrier()
#define PG8_SCHED __builtin_amdgcn_sched_barrier(0)
    Unit cur, nxt; int ui = 0;
    if (!S.next(0, cur)) return;
    if constexpr (Sched::GATHER) S.gather(cur, Rl, Cl, K, voffA);
    f32x4 acc[2][2][4][2];
#pragma unroll
    for (int a = 0; a < 2; ++a)
#pragma unroll
        for (int b = 0; b < 2; ++b)
#pragma unroll
            for (int m = 0; m < 4; ++m)
#pragma unroll
                for (int n = 0; n < 2; ++n) acc[a][b][m][n] = (f32x4){0.f, 0.f, 0.f, 0.f};
    struct Frag { v4i32 lo, hi; }; Frag At[4], B0[2], B1[2];
    const char* cA = S.a_base(cur); const char* cB = S.b_base(cur);
    PG8_STAGE(PG8_SB(0, 0), cB, voffB[0]); PG8_STAGE(PG8_SB(0, 1), cB, voffB[1]); PG8_STAGE(PG8_SA(0, 0), cA, voffA[0]); PG8_STAGE(PG8_SA(0, 1), cA, voffA[1]);
    if (wr == 1) PG8_BAR;
    PG8_WAIT_V(2); PG8_BAR;
    PG8_STAGE(PG8_SB(1, 0), cB + kstep, voffB[0]); PG8_STAGE(PG8_SA(1, 0), cA + kstep, voffA[0]); PG8_STAGE(PG8_SB(1, 1), cB + kstep, voffB[1]);
    PG8_WAIT_V(6); PG8_BAR;
    for (;;) {
        const bool has_next = S.next(ui + 1, nxt);
        const char* nA = has_next ? S.a_base(nxt) : cA; const char* nB = has_next ? S.b_base(nxt) : cB;
        if constexpr (Sched::GATHER) { if (has_next) S.gather(nxt, Rl, Cl, K, voffAn); else {
#pragma unroll
            for (int h = 0; h < 2; ++h)
#pragma unroll
                for (int i = 0; i < 2; ++i) voffAn[h][i] = voffA[h][i]; } }
#pragma clang loop unroll(disable)
        for (int t = 0; t < nt; t += 2) {
            const bool last = (t == nt - 2);
            const char* a1 = cA + (size_t)(t + 1) * kstep;
            const char* a2 = last ? nA : cA + (size_t)(t + 2) * kstep; const char* b2 = last ? nB : cB + (size_t)(t + 2) * kstep;
            const char* a3 = a2 + kstep; const char* b3 = b2 + kstep;
            unsigned vA2[2][2];
#pragma unroll
            for (int h = 0; h < 2; ++h)
#pragma unroll
                for (int i = 0; i < 2; ++i) vA2[h][i] = (Sched::GATHER && last) ? voffAn[h][i] : voffA[h][i];
            PG8_LDB(B0, 0, 0); PG8_LDB(B1, 0, 1); PG8_SCHED; PG8_LDA(At, 0, 0); PG8_STAGE(PG8_SA(1, 1), a1, voffA[1]);
            PG8_WAIT_V(8); PG8_WAIT_L(0); PG8_BAR; PG8_MMA(0, 0, At, B0); PG8_MMA(0, 1, At, B1); PG8_BAR; PG8_SCHED;
            PG8_LDA(At, 0, 1); PG8_STAGE(PG8_SB(0, 0), b2, voffB[0]); PG8_STAGE(PG8_SB(0, 1), b2, voffB[1]); PG8_STAGE(PG8_SA(0, 0), a2, vA2[0]);
            PG8_WAIT_V(8); PG8_WAIT_L(0); PG8_BAR; PG8_MMA(1, 0, At, B0); PG8_MMA(1, 1, At, B1); PG8_BAR; PG8_SCHED;
            PG8_LDB(B0, 1, 0); PG8_LDB(B1, 1, 1); PG8_SCHED; PG8_LDA(At, 1, 0); PG8_STAGE(PG8_SA(0, 1), a2, vA2[1]);
            PG8_WAIT_V(8); PG8_WAIT_L(0); PG8_BAR; PG8_MMA(0, 0, At, B0); PG8_MMA(0, 1, At, B1); PG8_BAR; PG8_SCHED;
            PG8_LDA(At, 1, 1); PG8_STAGE(PG8_SB(1, 0), b3, voffB[0]); PG8_STAGE(PG8_SB(1, 1), b3, voffB[1]); PG8_STAGE(PG8_SA(1, 0), a3, vA2[0]);
            PG8_WAIT_V(8); PG8_WAIT_L(0); PG8_BAR; PG8_MMA(1, 0, At, B0); PG8_MMA(1, 1, At, B1); PG8_BAR; PG8_SCHED;
        }
        if constexpr (ALIGN_EPI) { if (wr == 0) PG8_BAR; }
        if constexpr (!Epi::AFTER_DRAIN) { E(acc, cur, wr, wc, fr, fq); }
        if (!has_next) break;
#pragma unroll
        for (int a = 0; a < 2; ++a)
#pragma unroll
            for (int b = 0; b < 2; ++b)
#pragma unroll
                for (int m = 0; m < 4; ++m)
#pragma unroll
                    for (int n = 0; n < 2; ++n) acc[a][b][m][n] = (f32x4){0.f, 0.f, 0.f, 0.f};
        cur = nxt; cA = nA; cB = nB; ++ui;
        if constexpr (Sched::GATHER) {
#pragma unroll
            for (int h = 0; h < 2; ++h)
#pragma unroll
                for (int i = 0; i < 2; ++i) voffA[h][i] = voffAn[h][i]; }
        if constexpr (ALIGN_EPI) { if (wr == 1) PG8_BAR; }
    }
    PG8_WAIT_V(0);
    if constexpr (!ALIGN_EPI) { if (wr == 0) PG8_BAR; }
    PG8_BAR;
    if constexpr (Epi::AFTER_DRAIN) { E.fused(acc, cur, wr, wc, fr, fq, lds, wid, lane); }
#undef PG8_SA
#undef PG8_SB
#undef PG8_STAGE
#undef PG8_LDA
#undef PG8_LDB
#undef PG8_MMA
#undef PG8_WAIT_V
#undef PG8_WAIT_L
#undef PG8_BAR
#undef PG8_SCHED
}

struct DenseOrder {
    static constexpr bool GATHER = false;
    const char* A; const char* B; int K; size_t bbatch; int nM, nN, nwg, G, c;
    __device__ void init(const void* A_, const void* B_, int M, int N, int K_, size_t bbatch_, int G_, int c_) { A = (const char*)A_; B = (const char*)B_; K = K_; bbatch = bbatch_; nM = M / BM; nN = N / BM; nwg = nM * nN; G = G_; c = c_; }
    __device__ __forceinline__ bool next(int i, Unit& u) const {
        const long L = (long)i * G + c; if (L >= nwg) return false;
        int wgid = (int)L; { const int q = nwg / NXCD, r = nwg % NXCD, xcd = wgid % NXCD, off = wgid / NXCD; wgid = (xcd < r ? xcd * (q + 1) : r * (q + 1) + (xcd - r) * q) + off; }
        const int nig = WGM * nN, gid = wgid / nig, fm = gid * WGM, gsz = (nM - fm) < WGM ? (nM - fm) : WGM;
        u.pm = fm + ((wgid % nig) % gsz); u.pn = (wgid % nig) / gsz; u.e = 0; u.row0 = 0; u.nval = 256; u.lofs = 0; return true;
    }
    __device__ __forceinline__ const char* a_base(const Unit& u) const { return A + (size_t)u.pm * ((size_t)BM * K * 2); }
    __device__ __forceinline__ const char* b_base(const Unit& u) const { return B + (u.pm >= 32 ? bbatch : (size_t)0) + (size_t)u.pn * ((size_t)BM * K * 2); }
    __device__ __forceinline__ void gather(const Unit&, const int (&)[2], const int (&)[2], int, unsigned (&)[2][2]) const {}
};
}
namespace dat {
constexpr int SEQ = 8192, ZP = 2048;
constexpr int KSLOT = 8192, VSLOT = 8192, NKS = 8, NVS = 8, L_V = NKS * KSLOT, L_TAB = L_V + NVS * VSLOT, LDS_BYTES = L_TAB + 1024;
constexpr int KT_BLOCK = 16384;
constexpr float LOG2E = 1.4426950408889634f;
__device__ __forceinline__ void glds16(const void* gsrc, unsigned lds_dst) { unsigned keep;
    asm volatile("s_mov_b32 %0, m0\n\ts_mov_b32 m0, %2\n\ts_nop 0\n\tglobal_load_lds_dwordx4 %1, off\n\ts_mov_b32 m0, %0" : "=&s"(keep) : "v"(gsrc), "s"(lds_dst) : "memory"); }
#define DAT_WAIT_BAR(N) asm volatile("s_waitcnt vmcnt(" #N ") lgkmcnt(0)\n\ts_barrier" ::: "memory")
#define DAT_SB() __builtin_amdgcn_sched_barrier(0)
typedef short v4i16_t __attribute__((ext_vector_type(4)));
typedef short s16x4 __attribute__((ext_vector_type(4)));
__device__ __forceinline__ s16x4 vtr(LAS const char* p) { return __builtin_bit_cast(s16x4, __builtin_amdgcn_ds_read_tr16_b64_v4i16((LAS v4i16_t*)p)); }
__device__ __forceinline__ float max3f(float a, float b, float c) { float r; asm("v_max3_f32 %0, %1, %2, %3" : "=v"(r) : "v"(a), "v"(b), "v"(c)); return r; }
__device__ __forceinline__ float max2f(float a, float b) { float r; asm("v_max_f32_e32 %0, %1, %2" : "=v"(r) : "v"(a), "v"(b)); return r; }

__device__ __forceinline__ int rel_bucket(int rel) {
    const int n = rel < 0 ? -rel : rel; int b = rel > 0 ? 16 : 0;
    int l = n < 8 ? n : (n >= 91 ? 15 : n >= 64 ? 14 : n >= 46 ? 13 : n >= 32 ? 12 : n >= 23 ? 11 : n >= 16 ? 10 : n >= 12 ? 9 : 8);
    return b + l;
}

struct VFrag { v4i32 lo, hi; };
__device__ __forceinline__ void vread(VFrag& v, LAS const char* vp, int d) { v.lo = *(LAS const v4i32*)(vp + d * 2048); v.hi = *(LAS const v4i32*)(vp + d * 2048 + 16); }
template <bool SKIP = false>
__device__ __forceinline__ void pvmma(f32x16& o, const VFrag& v, const v8i32& pf) {
    if (SKIP) return;
    o = __builtin_amdgcn_mfma_scale_f32_32x32x64_f8f6f4(__builtin_shufflevector(v.lo, v.hi, 0, 1, 2, 3, 4, 5, 6, 7), pf, o, 0, 0, 0, 0, 0, 0);
}
__device__ __forceinline__ void kread(VFrag (&kf)[2], LAS const char* kp) {
#pragma unroll
    for (int j = 0; j < 2; ++j) { kf[j].lo = *(LAS const v4i32*)(kp + j * 512); kf[j].hi = *(LAS const v4i32*)(kp + 1024 + j * 512); }
}
template <bool COMP>
__device__ __forceinline__ void qkmma(f32x16& p0, f32x16& p1, const VFrag (&kf)[2], const v8i32& qf, const v8i32& ql, const f32x16& negm) {
    const v8i32 k0 = __builtin_shufflevector(kf[0].lo, kf[0].hi, 0, 1, 2, 3, 4, 5, 6, 7), k1 = __builtin_shufflevector(kf[1].lo, kf[1].hi, 0, 1, 2, 3, 4, 5, 6, 7);
    p0 = __builtin_amdgcn_mfma_scale_f32_32x32x64_f8f6f4(k0, qf, negm, 0, 0, 0, 0, 0, 0);
    p1 = __builtin_amdgcn_mfma_scale_f32_32x32x64_f8f6f4(k1, qf, negm, 0, 0, 0, 0, 0, 0);
    if constexpr (COMP) { p0 = __builtin_amdgcn_mfma_scale_f32_32x32x64_f8f6f4(k0, ql, p0, 0, 0, 0, 0, 0, 0); p1 = __builtin_amdgcn_mfma_scale_f32_32x32x64_f8f6f4(k1, ql, p1, 0, 0, 0, 0, 0, 0); }
}
template <int THRL>
__device__ __forceinline__ void softmax_max(bool first, f32x16& p0, f32x16& p1, f32x16& negm, float& mrun, f32x16& ol, f32x16 (&o)[4], bool near, int ib, LAS const float* tab) {
    if (near) {
#pragma unroll
        for (int r = 0; r < 16; ++r) { const int kk = (r & 3) + 8 * (r >> 2); p0[r] += tab[ib + kk]; p1[r] += tab[ib + kk + 32]; }
    }
    float ma = max3f(p0[0], p0[1], p0[2]), mb = max3f(p1[0], p1[1], p1[2]);
    ma = max3f(ma, p0[3], p0[4]); mb = max3f(mb, p1[3], p1[4]);
#pragma unroll
    for (int r = 5; r < 15; r += 2) { ma = max3f(ma, p0[r], p0[r + 1]); mb = max3f(mb, p1[r], p1[r + 1]); }
    float rm = max3f(ma, mb, p0[15]); rm = max2f(rm, p1[15]);
    { auto rr = __builtin_amdgcn_permlane32_swap(__float_as_uint(rm), __float_as_uint(rm), false, false); rm = max2f(__uint_as_float(rr[0]), __uint_as_float(rr[1])); }
    if (first || __any(rm > (float)THRL)) {
        const float dl = first ? rm : __builtin_fmaxf(rm, 0.f); mrun += dl;
        const float f = first ? 1.0f : __builtin_amdgcn_exp2f(-dl); ol[0] *= f;
#pragma unroll
        for (int r = 0; r < 16; ++r) { p0[r] -= dl; p1[r] -= dl; negm[r] = -mrun; }
#pragma unroll
        for (int d = 0; d < 4; ++d)
#pragma unroll
            for (int r = 0; r < 16; ++r) o[d][r] *= f;
    }
}
template <bool NOEXP = false>
__device__ __forceinline__ void softmax_exp(f32x16& p0, f32x16& p1, v8i32& pf) {
#define DAT_E2(x) (NOEXP ? (x) : __builtin_amdgcn_exp2f(x))
#pragma unroll
    for (int g = 0; g < 4; ++g) {
        const float e0 = DAT_E2(p0[4 * g]), e1 = DAT_E2(p0[4 * g + 1]), e2 = DAT_E2(p0[4 * g + 2]), e3 = DAT_E2(p0[4 * g + 3]);
        pf[g] = (int)pk4_fp8(e0, e1, e2, e3); DAT_SB();
    }
#pragma unroll
    for (int g = 0; g < 4; ++g) {
        const float e0 = DAT_E2(p1[4 * g]), e1 = DAT_E2(p1[4 * g + 1]), e2 = DAT_E2(p1[4 * g + 2]), e3 = DAT_E2(p1[4 * g + 3]);
        pf[4 + g] = (int)pk4_fp8(e0, e1, e2, e3); DAT_SB();
    }
}

struct Ctx { const unsigned char* tsrc; unsigned kdst, vdst; int wid, NT, tl, q0w, r32, hi; LAS const char* kp0; LAS const char* vp0; LAS const float* tab; };
#define DAT_DMA_K(C, t) glds16((C).tsrc + (size_t)(t) * KT_BLOCK, (unsigned)__builtin_amdgcn_readfirstlane((C).kdst + ((t) & 7) * KSLOT))
#define DAT_DMA_V(C, t) glds16((C).tsrc + (size_t)(t) * KT_BLOCK + 8192, (unsigned)__builtin_amdgcn_readfirstlane((C).vdst + ((t) & 7) * VSLOT))
#define DAT_WINDOW(C, t) do { if (MODE != 2) DAT_WAIT_BAR(0); if (MODE != 1 && MODE != 2 && (t) + 2 < (C).NT) { DAT_DMA_V(C, (t) + 2); DAT_DMA_K(C, (t) + 3); DAT_DMA_V(C, (t) + 3); if ((t) + 4 < (C).NT) DAT_DMA_K(C, (t) + 4); } } while (0)

#define DAT_VBLK(c0, c1, tau) do { \
        const int tau_ = (tau); \
        if (tau_ + 1 <= C.tl && MODE != 5) kread(kf, C.kp0 + ((tau_ + 1) & 7) * KSLOT); \
        DAT_SB(); \
        if (tau_ <= C.tl) { const bool near = 64 * tau_ > C.q0w - 191; const int ib = 64 * tau_ - C.q0w + 191 - C.r32 + 4 * C.hi; \
            int fv = (tau_ == 0); asm volatile("" : "+v"(fv)); const int fl = __builtin_amdgcn_readfirstlane(fv); \
            softmax_max<THRL>(fl != 0, c0, c1, negm, mrun, ol, o, near, ib, C.tab); DAT_SB(); \
            if (MODE != 5) vread(vA, C.vp0 + (tau_ & 7) * VSLOT, 0); DAT_SB(); \
            softmax_exp<MODE == 3>(c0, c1, pf); } \
        DAT_SB(); \
    } while (0)
#define DAT_MBLK(c0, c1, tau) do { \
        const int tau_ = (tau); \
        if (tau_ + 1 <= C.tl) qkmma<COMP>(c0, c1, kf, qf, ql, negm); \
        DAT_SB(); \
        if (tau_ <= C.tl) { LAS const char* vp = C.vp0 + (tau_ & 7) * VSLOT; VFrag vB = {}; \
            ol = __builtin_amdgcn_mfma_scale_f32_32x32x64_f8f6f4(ones, pf, ol, 0, 0, 0, 0, 0, 0); \
            DAT_SB(); if (MODE != 5) vread(vB, vp, 1); DAT_SB(); pvmma<MODE == 4>(o[0], vA, pf); DAT_SB(); \
            if (MODE != 5) vread(vA, vp, 2); DAT_SB(); pvmma<MODE == 4>(o[1], vB, pf); DAT_SB(); \
            if (MODE != 5) vread(vB, vp, 3); DAT_SB(); pvmma<MODE == 4>(o[2], vA, pf); DAT_SB(); \
            pvmma<MODE == 4>(o[3], vB, pf); DAT_SB(); } \
    } while (0)
template <int THRL, bool COMP, bool LAG, int MODE>
__device__ __forceinline__ void loop_p(const Ctx& C, const v8i32& qf, const v8i32& ql, f32x16 (&o)[4], float& lsum) {
    float mrun = 0.f; f32x16 negm = f32x16{}; v8i32 pf = v8i32{}; f32x16 ol = f32x16{};
    const int onew = C.r32 == 0 ? 0x38383838 : 0; const v8i32 ones = (v8i32){onew, onew, onew, onew, onew, onew, onew, onew};
    f32x16 a0, a1; VFrag kf[2] = {}, vA = {};
    DAT_WINDOW(C, 0);
    if (MODE != 5) kread(kf, C.kp0); DAT_SB(); qkmma<COMP>(a0, a1, kf, qf, ql, negm); DAT_SB();
    asm volatile("s_nop 15\n\ts_nop 7" : "+v"(a0), "+v"(a1));
    if constexpr (!LAG) {
        for (int t = 0;; t += 2) {
            DAT_VBLK(a0, a1, t); DAT_MBLK(a0, a1, t); DAT_VBLK(a0, a1, t + 1); DAT_MBLK(a0, a1, t + 1);
            if (t + 2 >= C.NT) break;
            DAT_WINDOW(C, t + 2);
        }
    } else {
        DAT_VBLK(a0, a1, 0); DAT_MBLK(a0, a1, 0); DAT_VBLK(a0, a1, 1);
        for (int t = 2; t < C.NT; t += 2) {
            DAT_WINDOW(C, t);
            DAT_MBLK(a0, a1, t - 1); DAT_VBLK(a0, a1, t); DAT_MBLK(a0, a1, t); DAT_VBLK(a0, a1, t + 1);
        }
        DAT_MBLK(a0, a1, C.NT - 1);
    }
    lsum = ol[0];
}
template <int THRL, int MODE = 0>
__device__ __forceinline__ void attn_unit(int b, int h, int xb, const bf16* __restrict__ Z, const unsigned char* __restrict__ KT, bf16* __restrict__ A2, const float* __restrict__ rel_bias, const float* __restrict__ subln, float lam, LAS char* shm) {
    int tid = threadIdx.x; asm volatile("" : "+v"(tid));
    const int lane = tid & 63, r32 = lane & 31, hi = lane >> 5; const int wid = __builtin_amdgcn_readfirstlane(tid >> 6);
    const int mp = wid >> 2, rw = wid & 3;
    const long rowbase = (long)b * SEQ; const int q0 = xb * 128, q0w = q0 + 32 * rw;
    const unsigned lds0 = (unsigned)(uintptr_t)shm;
    LAS float* tab = (LAS float*)(shm + L_TAB);
    { int tv = tid; asm volatile("" : "+v"(tv));
      if (tv < 255) { const int rel = tv - 191; tab[tv] = (rel_bias[rel_bucket(rel) * 4 + h] - rel_bias[15 * 4 + h]) * LOG2E; } }
    const bf16* Qw = Z + (rowbase + q0w + r32) * ZP + h * 128 + mp * 64 + hi * 32;
    v8i32 qf, ql;
#pragma unroll
    for (int ks = 0; ks < 4; ++ks) { const u32x4 qq = *(const u32x4*)(Qw + 8 * ks);
        const float q0 = bflo(qq.x), q1 = bfhi(qq.x), q2 = bflo(qq.y), q3 = bfhi(qq.y), q4 = bflo(qq.z), q5 = bfhi(qq.z), q6 = bflo(qq.w), q7 = bfhi(qq.w);
        const int a = (int)pk4_fp8(q0, q1, q2, q3), c = (int)pk4_fp8(q4, q5, q6, q7); qf[2 * ks] = a; qf[2 * ks + 1] = c;
        ql[2 * ks] = (int)pk4_fp8(q0 - __builtin_amdgcn_cvt_f32_fp8(a, 0), q1 - __builtin_amdgcn_cvt_f32_fp8(a, 1), q2 - __builtin_amdgcn_cvt_f32_fp8(a, 2), q3 - __builtin_amdgcn_cvt_f32_fp8(a, 3));
        ql[2 * ks + 1] = (int)pk4_fp8(q4 - __builtin_amdgcn_cvt_f32_fp8(c, 0), q5 - __builtin_amdgcn_cvt_f32_fp8(c, 1), q6 - __builtin_amdgcn_cvt_f32_fp8(c, 2), q7 - __builtin_amdgcn_cvt_f32_fp8(c, 3)); }
    asm volatile("" : "+v"(qf), "+v"(ql));
    Ctx C;
    C.tsrc = KT + (size_t)((b * 4 + h) * 128) * KT_BLOCK + wid * 1024 + lane * 16;
    C.kdst = lds0 + wid * 1024; C.vdst = lds0 + L_V + wid * 1024; C.wid = wid;
    C.NT = 2 * (xb + 1);
    C.tl = q0w >> 6;
    C.q0w = q0w; C.r32 = r32; C.hi = hi; C.tab = tab;
    C.kp0 = (LAS const char*)shm + mp * 4096 + hi * 2048 + r32 * 16;
    C.vp0 = (LAS const char*)shm + L_V + hi * 1024 + r32 * 32;
    if (MODE != 1 && MODE != 2) { DAT_DMA_K(C, 0); DAT_DMA_K(C, 1); DAT_DMA_V(C, 0); DAT_DMA_V(C, 1); if (C.NT > 2) DAT_DMA_K(C, 2); }
    float lsum = 0.f;
    f32x16 o[4]; o[0] = f32x16{}; o[1] = f32x16{}; o[2] = f32x16{}; o[3] = f32x16{};
    if (mp == 0) loop_p<THRL, true, false, MODE>(C, qf, ql, o, lsum); else loop_p<THRL, false, true, MODE>(C, qf, ql, o, lsum);
    { auto rr = __builtin_amdgcn_permlane32_swap(__float_as_uint(lsum), __float_as_uint(lsum), false, false); lsum = __uint_as_float(rr[0]) + __uint_as_float(rr[1]); }
    const float inv = 1.0f / lsum;
    DAT_WAIT_BAR(0);
    LAS float* ex = (LAS float*)shm + rw * 4096 + lane;
    if (mp == 1) {
        const float sc = inv * lam;
#pragma unroll
        for (int d = 0; d < 4; ++d)
#pragma unroll
            for (int r = 0; r < 16; ++r) ex[(d * 16 + r) * 64] = o[d][r] * sc;
    }
    DAT_WAIT_BAR(0);
    if (mp == 0) {
        float ss = 0.f;
#pragma unroll
        for (int d = 0; d < 4; ++d)
#pragma unroll
            for (int r = 0; r < 16; ++r) { const float a = o[d][r] * inv - ex[(d * 16 + r) * 64]; o[d][r] = a; ss += a * a; }
        { auto rr = __builtin_amdgcn_permlane32_swap(__float_as_uint(ss), __float_as_uint(ss), false, false); ss = __uint_as_float(rr[0]) + __uint_as_float(rr[1]); }
        const float rs = 0.8f / __builtin_sqrtf(ss * (1.0f / 128.0f) + 1e-6f);
        bf16* orow = A2 + (rowbase + q0w + r32) * 1024 + h * 128 + 4 * hi;
#pragma unroll
        for (int d = 0; d < 4; ++d)
#pragma unroll
            for (int g = 0; g < 4; ++g) {
                const f32x4 gn = *(const f32x4*)(subln + 32 * d + 8 * g + 4 * hi);
                u32x2 w; w.x = cvtpk(o[d][4 * g] * rs * gn[0], o[d][4 * g + 1] * rs * gn[1]); w.y = cvtpk(o[d][4 * g + 2] * rs * gn[2], o[d][4 * g + 3] * rs * gn[3]);
                st8(orow + 32 * d + 8 * g, w);
            }
    }
    DAT_WAIT_BAR(0);
}
}
constexpr int NWAVES = 8;
constexpr int BATCH = 2, SEQ = 8192, D = 1024, M = BATCH * SEQ, MEM = 256, NEXP = 16, FF = 256;
constexpr float EPS = 1e-6f, LOG2E = 1.4426950408889634f;
constexpr float C2 = 0.125f * LOG2E;
constexpr float CX = 0.0625f * LOG2E;
#ifndef MK_N_LAUNCHES
#define MK_N_LAUNCHES 1
#endif
constexpr int N_PHASES = 10;

constexpr size_t MiB = 1u << 20;
constexpr size_t WS_CTL = 0, CTL_ZERO_BYTES = 65536;
constexpr size_t WS_SSQ1 = 1 * MiB, WS_SSQ2 = 2 * MiB, WS_LIST = 3 * MiB, WS_LISTR = 4 * MiB, WS_LISTW = 5 * MiB, WS_WR = 6 * MiB  , WS_MN = 7 * MiB, WS_KVC = 8 * MiB;
constexpr size_t WS_WINT = 10 * MiB, WS_WOUTT = 14 * MiB, WS_WQN = 16 * MiB, WS_WKVT = 18 * MiB, WS_WOT = 22 * MiB, WS_WGUT = 24 * MiB, WS_WDT = 40 * MiB, WS_BTS = 48 * MiB, WS_BTO = 52 * MiB;
constexpr size_t WS_RA = 56 * MiB;
constexpr size_t WS_RB = 88 * MiB;
constexpr size_t WS_RC = 152 * MiB;
constexpr size_t WS_RD = 184 * MiB;
constexpr size_t WS_XB = 216 * MiB;
constexpr size_t WS_WGUT8 = 248 * MiB;
constexpr size_t WS_END = 256 * MiB;
constexpr size_t WS_WTMP = WS_BTS;
constexpr size_t WS_PWS = WS_BTO;
constexpr size_t WS_RSX = WS_SSQ2;
constexpr int CW_BAR = 4096, XCD_BAR_WORDS_C = 3456;
static_assert(CW_BAR + XCD_BAR_WORDS_C <= 8192 && (8192 + 16 * 64) * 4 <= 65536, "control words inside the memset region");
constexpr int CW_PAN = 9216;
static_assert((CW_PAN + 3 * 64 * 16) * 4 <= 65536, "panel counters inside the memset region");
constexpr int CW_XCC = 12288;
constexpr int CW_CNT = 8192;

constexpr int RING_OFF = 0, RING_BYTES = 148480;
constexpr int LDSCTL_OFF = RING_BYTES, MISC_OFF = LDSCTL_OFF + 320;
constexpr int LTAB_OFF = LDSCTL_OFF + 1024;
constexpr int LDS_BYTES = 163840;
static_assert(dat::LDS_BYTES <= RING_BYTES, "attention scratch inside the ring region");

typedef GAS unsigned gu32;
#define RLX_AGENT __ATOMIC_RELAXED, __HIP_MEMORY_SCOPE_AGENT
#define LDS_WAIT() asm volatile("s_waitcnt lgkmcnt(0)" ::: "memory")
#define VM_WAIT() asm volatile("s_waitcnt vmcnt(0)" ::: "memory")

#define XB_TMO      128
#define XB_XCNT(j)  (256  + 64 * (j))
#define XB_XSUB(j)  (1280 + 64 * (j))
#define XB_XGEN(j)  (2304 + 64 * (j))
#define XB_TOP      3328
#define XB_TOPGEN   3392
#define XCD_BAR_WORDS 3456
#define XB_SPIN_CAP (1u << 18)

__device__ __forceinline__ unsigned xb_ld(unsigned* p)              { return __hip_atomic_load(p, __ATOMIC_RELAXED, __HIP_MEMORY_SCOPE_AGENT); }
__device__ __forceinline__ unsigned xb_add(unsigned* p, unsigned v) { return __hip_atomic_fetch_add(p, v, __ATOMIC_RELAXED, __HIP_MEMORY_SCOPE_AGENT); }
__device__ __forceinline__ unsigned xb_xcc_id() { return (unsigned)__builtin_amdgcn_s_getreg((3 << 11) | 20) & 0xFu; }
#define XB_SPIN(cond, bar) do { unsigned _sp = 0; while (cond) { __builtin_amdgcn_s_sleep(1); \
    if ((++_sp & 255u) == 0u) { if (xb_ld(&(bar)[XB_TMO])) break; if (_sp > XB_SPIN_CAP) { atomicAdd(&(bar)[XB_TMO], 1u); break; } } } } while (0)

struct XcdBarrier {
    unsigned* bar; unsigned x;
    volatile LAS unsigned* st;
};
__device__ __forceinline__ XcdBarrier xcd_barrier_post(unsigned* bar, volatile LAS unsigned* st) {
    XcdBarrier b; b.bar = bar; b.x = xb_xcc_id(); b.st = st;
    if (threadIdx.x == 0) (void)xb_add(&bar[XB_XCNT(b.x)], 1u);
    return b;
}
__device__ __forceinline__ void xcd_barrier_complete(unsigned* bar, unsigned x, unsigned& nloc, unsigned& nx) {
    const unsigned G = gridDim.x * gridDim.y * gridDim.z;
    unsigned sum, cnt, mine, sp = 0u;
    for (;;) {
        sum = 0u; cnt = 0u; mine = 0u;
#pragma unroll
        for (unsigned j = 0; j < 16; ++j) { const unsigned c = xb_ld(&bar[XB_XCNT(j)]); sum += c; cnt += (c > 0u) ? 1u : 0u; mine = (j == x) ? c : mine; }
        if (sum == G) break;
        __builtin_amdgcn_s_sleep(1);
        if ((++sp & 255u) == 0u) { if (xb_ld(&bar[XB_TMO])) break; if (sp > XB_SPIN_CAP) { atomicAdd(&bar[XB_TMO], 1u); break; } }
    }
    nloc = mine > 0u ? mine : 1u; nx = cnt > 0u ? cnt : 1u;
}
__device__ __forceinline__ void xcd_barrier(const XcdBarrier& b) {
    asm volatile("s_waitcnt vmcnt(0)" ::: "memory");
    __syncthreads();
    if (threadIdx.x == 0) {
        unsigned* bar = b.bar;
        __builtin_amdgcn_s_waitcnt(0);
        unsigned nloc = b.st[0], nx = b.st[1];
        if (nloc == 0u) { xcd_barrier_complete(bar, b.x, nloc, nx); b.st[0] = nloc; b.st[1] = nx; }
        const unsigned old = xb_add(&bar[XB_XSUB(b.x)], 1u);
        const unsigned gen = old / nloc;
        if (old + 1u == (gen + 1u) * nloc) {
            __builtin_amdgcn_fence(__ATOMIC_RELEASE, "agent");
            asm volatile("s_waitcnt vmcnt(0)" ::: "memory");
            const unsigned og = xb_add(&bar[XB_TOP], 1u);
            const unsigned tg = og / nx;
            if (og + 1u == (tg + 1u) * nx) {
#pragma unroll
                for (unsigned j = 0; j < 16; ++j) xb_add(&bar[XB_XGEN(j)], 1u);
            } else XB_SPIN(xb_ld(&bar[XB_XGEN(b.x)]) == gen, bar);
            __builtin_amdgcn_fence(__ATOMIC_ACQUIRE, "agent");
            asm volatile("s_waitcnt vmcnt(0)" ::: "memory");
        } else {
            XB_SPIN(xb_ld(&bar[XB_XGEN(b.x)]) == gen, bar);
            __builtin_amdgcn_fence(__ATOMIC_ACQUIRE, "agent");
            asm volatile("s_waitcnt vmcnt(0)" ::: "memory");
        }
    }
    __syncthreads();
}

__device__ __forceinline__ void panel_signal(unsigned* cnt, bool local) {
    asm volatile("s_waitcnt vmcnt(0)" ::: "memory");
    __syncthreads();
    if (threadIdx.x == 0) { if (!local) { __builtin_amdgcn_fence(__ATOMIC_RELEASE, "agent"); asm volatile("s_waitcnt vmcnt(0)" ::: "memory"); } (void)xb_add(cnt, 1u); }
}
__device__ __forceinline__ void panel_wait(unsigned* cnt, unsigned need, unsigned* tmo) {
    if (threadIdx.x == 0) { XB_SPIN(xb_ld(cnt) < need, tmo - XB_TMO); __builtin_amdgcn_fence(__ATOMIC_ACQUIRE, "agent"); asm volatile("s_waitcnt vmcnt(0)" ::: "memory"); }
    __syncthreads();
}

struct Frame {
    LAS unsigned char* lds;
    volatile LAS unsigned* MISC;
    gu32* ctl;
    int tid, lane, wave;
    int vcu, G;
    const float* in[27]; float* out; unsigned char* ws;
};
enum { I_X = 0, I_MEM, I_RELB, I_ANORM, I_WIN, I_LQ1, I_LK1, I_LQ2, I_LK2, I_SUBLN, I_POOLW, I_POOLS, I_WOUT, I_CNORM, I_MNORM, I_WQ, I_WKV, I_WO, I_FNORM, I_RG, I_RGB, I_RE, I_REB, I_WG, I_WU, I_WD, I_FINAL };

__device__ __forceinline__ float wave_sum(float v) {
#pragma unroll
    for (int o = 1; o < 64; o <<= 1) v += __shfl_xor(v, o);
    return v;
}

__device__ __forceinline__ void p0_transpose_load(float (&v)[32], const float* W, int ldw, int k0, int n0, int lane) {
    const float* src = W + (size_t)(k0 + (lane >> 5)) * ldw + n0 + (lane & 31);
#pragma unroll
    for (int i = 0; i < 32; ++i) v[i] = __builtin_nontemporal_load(src + (size_t)(2 * i) * ldw);
}
__device__ __forceinline__ void p0_transpose_store(float (&v)[32], int k0, bf16* WT, int ldt, int drow0, int dcol0, const float* gain, LAS float* scr, int lane, unsigned char* WT8 = nullptr, float s8 = 1.f) {
    if (gain) {
#pragma unroll
        for (int i = 0; i < 32; ++i) v[i] *= gain[k0 + 2 * i + (lane >> 5)]; }
#pragma unroll
    for (int i = 0; i < 32; ++i) scr[(2 * i + (lane >> 5)) * 33 + (lane & 31)] = v[i];
    LDS_WAIT(); asm volatile("" ::: "memory");
    const int c = lane & 7;
#pragma unroll
    for (int j = 0; j < 4; ++j) { const int n = (lane >> 3) + 8 * j; const LAS float* s = scr + (8 * c) * 33 + n;
        u32x4 o; o.x = cvtpk(s[0 * 33], s[1 * 33]); o.y = cvtpk(s[2 * 33], s[3 * 33]); o.z = cvtpk(s[4 * 33], s[5 * 33]); o.w = cvtpk(s[6 * 33], s[7 * 33]);
        if (WT) *(GAS u32x4*)(WT + (size_t)(drow0 + n) * ldt + dcol0 + 8 * c) = o;
        if (WT8) { u32x2 o8; o8.x = pk4_fp8(s[0 * 33] * s8, s[1 * 33] * s8, s[2 * 33] * s8, s[3 * 33] * s8); o8.y = pk4_fp8(s[4 * 33] * s8, s[5 * 33] * s8, s[6 * 33] * s8, s[7 * 33] * s8);
            *(GAS u32x2*)(WT8 + (size_t)(drow0 + n) * ldt + dcol0 + 8 * c) = o8; } }
    LDS_WAIT(); asm volatile("" ::: "memory");
}
__device__ __forceinline__ void p0_transpose_item(const float* W, int ldw, int k0, int n0, bf16* WT, int ldt, int drow0, int dcol0, const float* gain, LAS float* scr, int lane) {
    float v[32]; p0_transpose_load(v, W, ldw, k0, n0, lane); p0_transpose_store(v, k0, WT, ldt, drow0, dcol0, gain, scr, lane);
}
template <int NR>
__device__ __forceinline__ void rms_rows_to_bf16(const float* xrow, const float* g, bf16* orow, int lane) {
    const GAS f32x4* gr = (const GAS f32x4*)g + lane;
    f32x4 v[NR][4]; float s[NR];
#pragma unroll
    for (int r = 0; r < NR; ++r) { const GAS f32x4* xr = (const GAS f32x4*)(xrow + (size_t)r * D) + lane;
#pragma unroll
        for (int j = 0; j < 4; ++j) v[r][j] = __builtin_nontemporal_load(xr + 64 * j); }
#pragma unroll
    for (int r = 0; r < NR; ++r) { s[r] = 0.f;
#pragma unroll
        for (int j = 0; j < 4; ++j) s[r] += (v[r][j].x * v[r][j].x + v[r][j].y * v[r][j].y) + (v[r][j].z * v[r][j].z + v[r][j].w * v[r][j].w); }
#pragma unroll
    for (int r = 0; r < NR; ++r) { const float rstd = 1.f / __builtin_sqrtf(wave_sum(s[r]) * (1.f / D) + EPS);
        GAS u32x2* o8 = (GAS u32x2*)(orow + (size_t)r * D) + lane;
#pragma unroll
        for (int j = 0; j < 4; ++j) { const f32x4 gg = gr[64 * j]; u32x2 w; w.x = cvtpk(v[r][j].x * rstd * gg.x, v[r][j].y * rstd * gg.y); w.y = cvtpk(v[r][j].z * rstd * gg.z, v[r][j].w * rstd * gg.w); o8[64 * j] = w; } }
}

template <int NR>
__device__ __forceinline__ void rows_to_bf16_rstd(const float* xrow, bf16* orow, float* rstd_out, int lane) {
    f32x4 v[NR][4]; float s[NR];
#pragma unroll
    for (int r = 0; r < NR; ++r) { const GAS f32x4* xr = (const GAS f32x4*)(xrow + (size_t)r * D) + lane;
#pragma unroll
        for (int j = 0; j < 4; ++j) v[r][j] = __builtin_nontemporal_load(xr + 64 * j); }
#pragma unroll
    for (int r = 0; r < NR; ++r) { s[r] = 0.f; GAS u32x2* o8 = (GAS u32x2*)(orow + (size_t)r * D) + lane;
#pragma unroll
        for (int j = 0; j < 4; ++j) { s[r] += (v[r][j].x * v[r][j].x + v[r][j].y * v[r][j].y) + (v[r][j].z * v[r][j].z + v[r][j].w * v[r][j].w);
            u32x2 w; w.x = cvtpk(v[r][j].x, v[r][j].y); w.y = cvtpk(v[r][j].z, v[r][j].w); o8[64 * j] = w; } }
#pragma unroll
    for (int r = 0; r < NR; ++r) { const float t = wave_sum(s[r]); if (lane == 0) rstd_out[r] = 1.f / __builtin_sqrtf(t * (1.f / D) + EPS); }
}

template <int KS = 8, class Store>
__device__ __forceinline__ void small_gemm64(const bf16* A, int lda, const bf16* B, int ldb, int K, int wave, int lane, const Store& st) {
    const int fr = lane & 15, fq = lane >> 4;
    const bf16* ap = A + (size_t)(16 * (wave & 3) + fr) * lda + 8 * fq;
    const bf16* bp0 = B + (size_t)(32 * (wave >> 2) + fr) * ldb + 8 * fq;
    const bf16* bp1 = bp0 + (size_t)16 * ldb;
    f32x4 acc0 = {0.f, 0.f, 0.f, 0.f}, acc1 = {0.f, 0.f, 0.f, 0.f};
    for (int k = 0; k < K; k += 32 * KS) {
        bf16x8 a[KS], b0[KS], b1[KS];
#pragma unroll
        for (int s = 0; s < KS; ++s) { a[s] = *(const GAS bf16x8*)(ap + k + 32 * s); b0[s] = *(const GAS bf16x8*)(bp0 + k + 32 * s); b1[s] = *(const GAS bf16x8*)(bp1 + k + 32 * s); }
#pragma unroll
        for (int s = 0; s < KS; ++s) { acc0 = __builtin_amdgcn_mfma_f32_16x16x32_bf16(b0[s], a[s], acc0, 0, 0, 0); acc1 = __builtin_amdgcn_mfma_f32_16x16x32_bf16(b1[s], a[s], acc1, 0, 0, 0); }
    }
    const int row = 16 * (wave & 3) + fr, col = 32 * (wave >> 2) + 4 * fq;
    st(row, col, acc0); st(row, col + 16, acc1);
}
struct TileJob { const bf16* A; const bf16* B; bf16* C; int lda, ldb, ldc; int c8; };
template <class Get> struct PlainJobs { Get get;
    __device__ __forceinline__ const bf16* arow(int j, int lane) const { const TileJob t = get(j); return t.A + (size_t)lane * t.lda; }
    __device__ __forceinline__ const bf16* brow(int j, int lane) const { const TileJob t = get(j); return t.B + (size_t)lane * t.ldb; }
    __device__ __forceinline__ void store(int j, int wave, int lane, f32x4 acc0, f32x4 acc1) const { const TileJob t = get(j);
        if (t.c8) { unsigned char* c8p = (unsigned char*)t.C + (size_t)(16 * (wave & 3) + (lane & 15)) * t.ldc + 32 * (wave >> 2) + 4 * (lane >> 4);
            *(GAS unsigned*)c8p = pk4_fp8(acc0[0], acc0[1], acc0[2], acc0[3]); *(GAS unsigned*)(c8p + 16) = pk4_fp8(acc1[0], acc1[1], acc1[2], acc1[3]); return; }
        bf16* cp = t.C + (size_t)(16 * (wave & 3) + (lane & 15)) * t.ldc + 32 * (wave >> 2) + 4 * (lane >> 4);
        u32x2 w; w.x = cvtpk(acc0[0], acc0[1]); w.y = cvtpk(acc0[2], acc0[3]); *(GAS u32x2*)cp = w; w.x = cvtpk(acc1[0], acc1[1]); w.y = cvtpk(acc1[2], acc1[3]); *(GAS u32x2*)(cp + 16) = w; }
};
template <int KCH, int NSTEP, bool F8 = false, class Jobs>
__device__ __forceinline__ void tile_pipe(LAS char* lds, int njobs, const Jobs& jobs, int wave, int lane) {
    constexpr int CPR = KCH / 8, RPP = 64 / CPR, ROWB = CPR * 16, OPB = 64 * ROWB, BUFB = 2 * OPB, PPO = 64 / RPP / 8;
    const unsigned lds0 = (unsigned)(uintptr_t)lds; const int fr = lane & 15, fq = lane >> 4;
    const int nsteps = njobs * NSTEP;
    if (nsteps <= 0) return;
    const int rip = lane / CPR, slot = lane % CPR;
    const bf16* ar_[PPO]; const bf16* br_[PPO];
#define TP_DMA(st, buf) do { const int k0_ = ((st) % NSTEP) * KCH; \
        if (k0_ == 0) { _Pragma("unroll") for (int i_ = 0; i_ < PPO; ++i_) { const int row_ = (wave * PPO + i_) * RPP + rip; const int ch_ = (slot & 16) | ((slot ^ row_) & 15); \
            ar_[i_] = jobs.arow((st) / NSTEP, row_) + 8 * ch_; br_[i_] = jobs.brow((st) / NSTEP, row_) + 8 * ch_; } } \
        _Pragma("unroll") for (int i_ = 0; i_ < PPO; ++i_) { \
            dat::glds16(ar_[i_] + k0_, (unsigned)__builtin_amdgcn_readfirstlane(lds0 + (buf) * BUFB + (wave * PPO + i_) * 1024)); \
            dat::glds16(br_[i_] + k0_, (unsigned)__builtin_amdgcn_readfirstlane(lds0 + (buf) * BUFB + OPB + (wave * PPO + i_) * 1024)); } } while (0)
    TP_DMA(0, 0);
    f32x4 acc0 = {0.f, 0.f, 0.f, 0.f}, acc1 = {0.f, 0.f, 0.f, 0.f};
    const int x0 = fq ^ fr;
    const int aoff = (16 * (wave & 3) + fr) * ROWB, boff = OPB + (32 * (wave >> 2) + fr) * ROWB;
    for (int st = 0; st < nsteps; ++st) {
        asm volatile("s_waitcnt vmcnt(0) lgkmcnt(0)\n\ts_barrier" ::: "memory");
        if (st + 1 < nsteps) TP_DMA(st + 1, (st + 1) & 1);
        LAS const char* bp = lds + (st & 1) * BUFB;
        if constexpr (F8) {
#pragma unroll
            for (int s3 = 0; s3 < KCH / 64; ++s3) {
                const int so0 = ((((8 * s3) ^ x0) & 15) | ((8 * s3) & 16)) * 16, so1 = ((((8 * s3 + 4) ^ x0) & 15) | ((8 * s3 + 4) & 16)) * 16;
                const v4i32 al = *(LAS const v4i32*)(bp + aoff + so0), ah = *(LAS const v4i32*)(bp + aoff + so1), b0l = *(LAS const v4i32*)(bp + boff + so0), b0h = *(LAS const v4i32*)(bp + boff + so1),
                            b1l = *(LAS const v4i32*)(bp + boff + 16 * ROWB + so0), b1h = *(LAS const v4i32*)(bp + boff + 16 * ROWB + so1);
                const v8i32 a8 = __builtin_shufflevector(al, ah, 0, 1, 2, 3, 4, 5, 6, 7), b08 = __builtin_shufflevector(b0l, b0h, 0, 1, 2, 3, 4, 5, 6, 7), b18 = __builtin_shufflevector(b1l, b1h, 0, 1, 2, 3, 4, 5, 6, 7);
                acc0 = __builtin_amdgcn_mfma_scale_f32_16x16x128_f8f6f4(b08, a8, acc0, 0, 0, 0, 0, 0, 0); acc1 = __builtin_amdgcn_mfma_scale_f32_16x16x128_f8f6f4(b18, a8, acc1, 0, 0, 0, 0, 0, 0);
            }
        } else {
#pragma unroll
        for (int s2 = 0; s2 < KCH / 32; ++s2) {
            const int so = ((((4 * s2) ^ x0) & 15) | ((4 * s2) & 16)) * 16;
            const bf16x8 a = *(LAS const bf16x8*)(bp + aoff + so), b0 = *(LAS const bf16x8*)(bp + boff + so), b1 = *(LAS const bf16x8*)(bp + boff + 16 * ROWB + so);
            acc0 = __builtin_amdgcn_mfma_f32_16x16x32_bf16(b0, a, acc0, 0, 0, 0); acc1 = __builtin_amdgcn_mfma_f32_16x16x32_bf16(b1, a, acc1, 0, 0, 0);
        }
        }
        if ((st % NSTEP) == NSTEP - 1) { jobs.store(st / NSTEP, wave, lane, acc0, acc1); acc0 = (f32x4){0.f, 0.f, 0.f, 0.f}; acc1 = (f32x4){0.f, 0.f, 0.f, 0.f}; }
    }
    asm volatile("s_waitcnt vmcnt(0) lgkmcnt(0)\n\ts_barrier" ::: "memory");
#undef TP_DMA
}
struct StoreBf16 { bf16* C; int ldc;
    __device__ __forceinline__ void operator()(int row, int col, f32x4 v) const { u32x2 w; w.x = cvtpk(v[0], v[1]); w.y = cvtpk(v[2], v[3]); *(GAS u32x2*)(C + (size_t)row * ldc + col) = w; } };
namespace pg8 {
struct EpiBf16 { static constexpr bool PERM = true, AFTER_DRAIN = false; bf16* O; int ldc; int scale_cols; float scale0;
    __device__ __forceinline__ void operator()(const f32x4 (&acc)[2][2][4][2], const Unit& u, int wr, int wc, int fr, int fq) const {
        const int row0 = u.pm * BM + wr * 64 + fr, colt = u.pn * BM; const float sc = colt < scale_cols ? scale0 : 1.f; const int col0 = colt + wc * 32 + 8 * fq;
#pragma unroll
        for (int ai = 0; ai < 2; ++ai)
#pragma unroll
            for (int m = 0; m < 4; ++m) { bf16* rowp = O + (size_t)(row0 + ai * HALF + m * 16) * ldc + col0;
#pragma unroll
                for (int bj = 0; bj < 2; ++bj) { const f32x4 v0 = acc[ai][bj][m][0] * sc, v1 = acc[ai][bj][m][1] * sc;
                    u32x4 w; w.x = cvtpk(v0[0], v0[1]); w.y = cvtpk(v0[2], v0[3]); w.z = cvtpk(v1[0], v1[1]); w.w = cvtpk(v1[2], v1[3]); st16(rowp + bj * HALF, w); } }
    }
};
struct EpiZ { static constexpr bool PERM = true, AFTER_DRAIN = false; bf16* Z; unsigned char* KT; float qscale; const float* rsx; LAS unsigned char* vscr;
    __device__ __forceinline__ void operator()(const f32x4 (&acc)[2][2][4][2], const Unit& u, int wr, int wc, int fr, int fq) const {
        const int kind = u.pn >> 1;
        float rs[2][4];
#pragma unroll
        for (int ai = 0; ai < 2; ++ai)
#pragma unroll
            for (int m = 0; m < 4; ++m) rs[ai][m] = rsx[u.pm * BM + ai * HALF + wr * 64 + m * 16 + fr];
        if (kind == 0 || kind == 3) {
            const int row0 = u.pm * BM + wr * 64 + fr, col0 = u.pn * BM + wc * 32 + 8 * fq; const float sc = kind == 0 ? qscale : 1.f;
#pragma unroll
            for (int ai = 0; ai < 2; ++ai)
#pragma unroll
                for (int m = 0; m < 4; ++m) { bf16* rowp = Z + (size_t)(row0 + ai * HALF + m * 16) * 2048 + col0; const float sr = sc * rs[ai][m];
#pragma unroll
                    for (int bj = 0; bj < 2; ++bj) { const f32x4 v0 = acc[ai][bj][m][0] * sr, v1 = acc[ai][bj][m][1] * sr;
                        u32x4 w; w.x = cvtpk(v0[0], v0[1]); w.y = cvtpk(v0[2], v0[3]); w.z = cvtpk(v1[0], v1[1]); w.w = cvtpk(v1[2], v1[3]); st16(rowp + bj * HALF, w); } }
        } else if (kind == 1) {
            const int b = u.pm >> 5, t0 = (u.pm & 31) * 4 + wr;
            const unsigned inb = (unsigned)((wc >> 1) * 4096 + ((wc & 1) * 2 + (fq >> 1)) * 1024 + fr * 16 + 8 * (fq & 1));
#pragma unroll
            for (int bj = 0; bj < 2; ++bj) { const int h = (u.pn & 1) * 2 + bj;
#pragma unroll
                for (int ai = 0; ai < 2; ++ai) { unsigned char* blk = KT + (size_t)(((b * 4 + h) * 128) + t0 + 2 * ai) * 16384 + inb;
#pragma unroll
                    for (int m = 0; m < 4; ++m) { const f32x4 v0 = acc[ai][bj][m][0] * rs[ai][m], v1 = acc[ai][bj][m][1] * rs[ai][m];
                        u32x2 w; w.x = pk4_fp8(v0[0], v0[1], v0[2], v0[3]); w.y = pk4_fp8(v1[0], v1[1], v1[2], v1[3]); st8(blk + m * 256, w); } } }
        } else {
            const int b = u.pm >> 5, t0 = (u.pm & 31) * 4 + wr; const int wave = wr * 4 + wc;
            LAS unsigned char* sc = vscr + wave * 2048; const int hik = (fr >> 2) & 1, r0 = (fr & 3) + 4 * (fr >> 3);
#pragma unroll
            for (int bj = 0; bj < 2; ++bj) { const int h = (u.pn & 1) * 2 + bj;
#pragma unroll
                for (int ai = 0; ai < 2; ++ai) {
#pragma unroll
                    for (int m = 0; m < 4; ++m) { const int bb = 16 * (m >> 1) + r0 + 8 * (m & 1);
#pragma unroll
                        for (int n = 0; n < 2; ++n)
#pragma unroll
                            for (int i = 0; i < 4; ++i) { const float x = acc[ai][bj][m][n][i] * rs[ai][m]; const int w = __builtin_amdgcn_cvt_pk_fp8_f32(x, x, 0, false);
                                sc[hik * 1024 + (8 * fq + 4 * n + i) * 32 + bb] = (unsigned char)w; } }
                    asm volatile("s_waitcnt lgkmcnt(0)" ::: "memory");
                    const int lane = fq * 16 + fr; const u32x4 o0 = *(const LAS u32x4*)(sc + lane * 32), o1 = *(const LAS u32x4*)(sc + lane * 32 + 16);
                    unsigned char* blk = KT + (size_t)(((b * 4 + h) * 128) + t0 + 2 * ai) * 16384 + 8192 + wc * 2048 + lane * 32;
                    st16(blk, o0); st16(blk + 16, o1);
                    asm volatile("s_waitcnt lgkmcnt(0)" ::: "memory"); } }
        }
    }
};
template <bool BASE_BF16, bool OUT8 = false> struct EpiRes { static constexpr bool PERM = true, AFTER_DRAIN = false; const void* base; bf16* outb; float* ssq; unsigned char* out8; float ascale;
    __device__ __forceinline__ void operator()(const f32x4 (&acc)[2][2][4][2], const Unit& u, int wr, int wc, int fr, int fq) const {
        const int row0 = u.pm * BM + wr * 64 + fr, col0 = u.pn * BM + wc * 32 + 8 * fq;
#pragma unroll
        for (int ai = 0; ai < 2; ++ai)
#pragma unroll
            for (int m = 0; m < 4; ++m) { const int row = row0 + ai * HALF + m * 16; const size_t off = (size_t)row * 1024 + col0; float ss = 0.f;
#pragma unroll
                for (int bj = 0; bj < 2; ++bj) { f32x4 b0, b1;
                    if (BASE_BF16) { const u32x4 bw = *(const u32x4*)((const bf16*)base + off + bj * HALF); b0 = (f32x4){bflo(bw.x), bfhi(bw.x), bflo(bw.y), bfhi(bw.y)}; b1 = (f32x4){bflo(bw.z), bfhi(bw.z), bflo(bw.w), bfhi(bw.w)}; }
                    else { b0 = *(const f32x4*)((const float*)base + off + bj * HALF); b1 = *(const f32x4*)((const float*)base + off + bj * HALF + 4); }
                    const f32x4 v0 = acc[ai][bj][m][0] * ascale + b0, v1 = acc[ai][bj][m][1] * ascale + b1;
                    u32x4 w; w.x = cvtpk(v0[0], v0[1]); w.y = cvtpk(v0[2], v0[3]); w.z = cvtpk(v1[0], v1[1]); w.w = cvtpk(v1[2], v1[3]); st16(outb + off + bj * HALF, w);
                    if constexpr (OUT8) { u32x2 w8; w8.x = pk4_fp8(v0[0], v0[1], v0[2], v0[3]); w8.y = pk4_fp8(v1[0], v1[1], v1[2], v1[3]); *(u32x2*)(out8 + off + bj * HALF) = w8; }
                    ss += (v0[0] * v0[0] + v0[1] * v0[1]) + (v0[2] * v0[2] + v0[3] * v0[3]) + (v1[0] * v1[0] + v1[1] * v1[1]) + (v1[2] * v1[2] + v1[3] * v1[3]); }
                ss += __shfl_xor(ss, 16); ss += __shfl_xor(ss, 32);
                if (fq == 0) ssq[(size_t)row * 16 + u.pn * 4 + wc] = ss;
                if (m == 3) asm volatile("" ::: "memory"); }
    }
};
struct EpiSoftmax { static constexpr bool PERM = true, AFTER_DRAIN = true; const float* ssq; unsigned char* P;
    __device__ __forceinline__ void operator()(const f32x4 (&)[2][2][4][2], const Unit&, int, int, int, int) const {}
    __device__ __forceinline__ void fused(f32x4 (&acc)[2][2][4][2], const Unit& u, int wr, int wc, int fr, int fq, LAS unsigned char* lds, int wid, int lane) const {
        LAS float* PM = (LAS float*)lds; LAS float* PS = PM + 1024;
#pragma unroll
        for (int ai = 0; ai < 2; ++ai)
#pragma unroll
            for (int m = 0; m < 4; ++m) { const int rt = ai * HALF + wr * 64 + m * 16 + fr; const f32x4* sp = (const f32x4*)(ssq + (size_t)(u.pm * BM + rt) * 16);
                const f32x4 s0 = sp[0], s1 = sp[1], s2 = sp[2], s3 = sp[3]; const f32x4 st = (s0 + s1) + (s2 + s3);
                const float rs = CX / __builtin_sqrtf(((st[0] + st[1]) + (st[2] + st[3])) * (1.0f / 1024.0f) + EPS);
                float mx = -3.0e38f;
#pragma unroll
                for (int bj = 0; bj < 2; ++bj)
#pragma unroll
                    for (int n = 0; n < 2; ++n) { f32x4 v = acc[ai][bj][m][n] * rs; acc[ai][bj][m][n] = v; mx = __builtin_fmaxf(mx, __builtin_fmaxf(__builtin_fmaxf(v[0], v[1]), __builtin_fmaxf(v[2], v[3]))); }
                mx = __builtin_fmaxf(mx, __shfl_xor(mx, 16)); mx = __builtin_fmaxf(mx, __shfl_xor(mx, 32));
                if (fq == 0) PM[rt * 4 + wc] = mx; }
        asm volatile("s_waitcnt lgkmcnt(0)" ::: "memory"); __builtin_amdgcn_s_barrier(); asm volatile("" ::: "memory");
#pragma unroll
        for (int ai = 0; ai < 2; ++ai)
#pragma unroll
            for (int m = 0; m < 4; ++m) { const int rt = ai * HALF + wr * 64 + m * 16 + fr; const f32x4 m4 = *(const LAS f32x4*)(PM + rt * 4);
                const float mx = __builtin_fmaxf(__builtin_fmaxf(m4[0], m4[1]), __builtin_fmaxf(m4[2], m4[3])); float sm = 0.f;
#pragma unroll
                for (int bj = 0; bj < 2; ++bj)
#pragma unroll
                    for (int n = 0; n < 2; ++n) { f32x4 v = acc[ai][bj][m][n]; v[0] = __builtin_amdgcn_exp2f(v[0] - mx); v[1] = __builtin_amdgcn_exp2f(v[1] - mx); v[2] = __builtin_amdgcn_exp2f(v[2] - mx); v[3] = __builtin_amdgcn_exp2f(v[3] - mx);
                        acc[ai][bj][m][n] = v; sm += (v[0] + v[1]) + (v[2] + v[3]); }
                sm += __shfl_xor(sm, 16); sm += __shfl_xor(sm, 32);
                if (fq == 0) PS[rt * 4 + wc] = sm; }
        asm volatile("s_waitcnt lgkmcnt(0)" ::: "memory"); __builtin_amdgcn_s_barrier(); asm volatile("" ::: "memory");
        const int col0 = u.pn * BM + wc * 32 + 8 * fq;
#pragma unroll
        for (int ai = 0; ai < 2; ++ai)
#pragma unroll
            for (int m = 0; m < 4; ++m) { const int rt = ai * HALF + wr * 64 + m * 16 + fr; const f32x4 s4 = *(const LAS f32x4*)(PS + rt * 4);
                const float inv = 256.0f / ((s4[0] + s4[1]) + (s4[2] + s4[3])); unsigned char* rowp = P + (size_t)(u.pm * BM + rt) * 1024 + col0;
#pragma unroll
                for (int bj = 0; bj < 2; ++bj) { const f32x4 v0 = acc[ai][bj][m][0] * inv, v1 = acc[ai][bj][m][1] * inv;
                    u32x2 w; w.x = pk4_fp8(v0[0], v0[1], v0[2], v0[3]); w.y = pk4_fp8(v1[0], v1[1], v1[2], v1[3]); *(u32x2*)(rowp + bj * HALF) = w; } }
    }
};
struct EpiGateUp { static constexpr bool PERM = true, AFTER_DRAIN = false; unsigned char* ACT; const float* listr; const float* listw; float ascale;
    __device__ __forceinline__ void operator()(const f32x4 (&acc)[2][2][4][2], const Unit& u, int wr, int wc, int fr, int fq) const {
#pragma unroll
        for (int ai = 0; ai < 2; ++ai)
#pragma unroll
            for (int m = 0; m < 4; ++m) { const int r = ai * HALF + wr * 64 + m * 16 + fr; const bool ok = r < u.nval;
                const float rs = ok ? listr[u.lofs + r] * ascale : 0.f, cw = ok ? listw[u.lofs + r] * 8.0f : 0.f; f32x4 a[2];
#pragma unroll
                for (int n = 0; n < 2; ++n)
#pragma unroll
                    for (int i = 0; i < 4; ++i) { const float g = acc[ai][0][m][n][i] * rs, up = acc[ai][1][m][n][i] * rs; a[n][i] = __builtin_amdgcn_fmed3f(g * __builtin_amdgcn_rcpf(1.0f + __builtin_amdgcn_exp2f(-g * LOG2E)) * up * cw, -448.0f, 448.0f); }
                u32x2 w; w.x = pk4_fp8(a[0][0], a[0][1], a[0][2], a[0][3]); w.y = pk4_fp8(a[1][0], a[1][1], a[1][2], a[1][3]);
                st8(ACT + (size_t)(u.row0 + r) * 256 + u.pn * HALF + wc * 32 + 8 * fq, w); }
    }
};
struct EpiDown { static constexpr bool PERM = true, AFTER_DRAIN = false; unsigned char* YS; const int* list; float ascale;
    __device__ __forceinline__ void operator()(const f32x4 (&acc)[2][2][4][2], const Unit& u, int wr, int wc, int fr, int fq) const {
        const unsigned colp = (unsigned)(u.pn * BM + wc * 32 + 8 * fq); const int* lp = list + u.lofs + wr * 64 + fr;
#pragma unroll
        for (int ai = 0; ai < 2; ++ai)
#pragma unroll
            for (int m = 0; m < 4; ++m) { const int r = ai * HALF + wr * 64 + m * 16 + fr;
                if (r < u.nval) { const unsigned v = (unsigned)lp[ai * HALF + m * 16]; const unsigned eo = ((((v & 1u) << 14) + (v >> 1)) << 10) + colp;
#pragma unroll
                    for (int bj = 0; bj < 2; ++bj) { const f32x4 v0 = acc[ai][bj][m][0] * ascale, v1 = acc[ai][bj][m][1] * ascale;
                        u32x2 w; w.x = pk4_fp8(__builtin_amdgcn_fmed3f(v0[0], -448.f, 448.f), __builtin_amdgcn_fmed3f(v0[1], -448.f, 448.f), __builtin_amdgcn_fmed3f(v0[2], -448.f, 448.f), __builtin_amdgcn_fmed3f(v0[3], -448.f, 448.f));
                        w.y = pk4_fp8(__builtin_amdgcn_fmed3f(v1[0], -448.f, 448.f), __builtin_amdgcn_fmed3f(v1[1], -448.f, 448.f), __builtin_amdgcn_fmed3f(v1[2], -448.f, 448.f), __builtin_amdgcn_fmed3f(v1[3], -448.f, 448.f)); st8(YS + eo + bj * HALF, w); } }
                asm volatile("" ::: "memory"); }
    }
};

template <int NCT, bool GATH> struct MoeOrder {
    static constexpr bool GATHER = GATH;
    LAS const int* tab; const char* A; const char* B; const int* list; int G, c, nunits; size_t bexp, btile; size_t apitch = FF * 2;
    __device__ __forceinline__ bool next(int i, Unit& u) const {
        const int L = i * G + c; if (L >= nunits) return false;
        const int rtg = L / NCT; int e = 0;
#pragma unroll
        for (int j = 1; j < 16; ++j) e += (rtg >= tab[64 + j]) ? 1 : 0;
        e = __builtin_amdgcn_readfirstlane(e);
        const int ptf = __builtin_amdgcn_readfirstlane(tab[64 + e]), pt = __builtin_amdgcn_readfirstlane(tab[e]); const int rt = rtg - ptf;
        u.pm = rt; u.pn = L % NCT; u.e = e; u.row0 = (pt + rt) * 256; u.nval = 256; u.lofs = e * 16384 + rt * 256; return true;
    }
    __device__ __forceinline__ const char* a_base(const Unit& u) const { return GATH ? A : A + (size_t)u.row0 * apitch; }
    __device__ __forceinline__ const char* b_base(const Unit& u) const { return B + (size_t)u.e * bexp + (size_t)u.pn * btile; }
    __device__ __forceinline__ void gather(const Unit& u, const int (&Rl)[2], const int (&Cl)[2], int K, unsigned (&vo)[2][2]) const {
#pragma unroll
        for (int h = 0; h < 2; ++h)
#pragma unroll
            for (int i = 0; i < 2; ++i) { const int r = Rl[i] + HALF * h; const int tok = list[u.lofs + r] >> 1; vo[h][i] = (unsigned)(tok * K + Cl[i]) * 2u; }
    }
};
}

__device__ __forceinline__ void p0_prologue(Frame& F) {
    LAS float* scr = (LAS float*)(F.lds + RING_OFF + F.wave * 16384);
    const int gw = F.vcu * NWAVES + F.wave, NGW = F.G * NWAVES, lane = F.lane;
    unsigned char* ws = F.ws;
    constexpr int N_A = 1024, N_B = 512, N_C = 1024, N_D = 512, N_H = 2048, N_I = 128, N_J = 512;
    constexpr int NITEMS = N_A + N_B + N_C + N_D + N_H + N_I + N_J;
    for (int m = gw; m < BATCH * MEM; m += NGW) rms_rows_to_bf16<1>(F.in[I_MEM] + (size_t)m * D, F.in[I_MNORM], (bf16*)(ws + WS_MN) + (size_t)m * D, lane);
    for (int m = 2 * gw; m < M; m += 2 * NGW) rows_to_bf16_rstd<2>(F.in[I_X] + (size_t)m * D, (bf16*)(ws + WS_XB) + (size_t)m * D, (float*)(ws + WS_RSX) + m, lane);
    for (int it = gw; it < NITEMS; it += NGW) {
        int r = it;
        if (r < N_A) { p0_transpose_item(F.in[I_WIN], 2048, (r >> 6) * 64, (r & 63) * 32, (bf16*)(ws + WS_WINT), 1024, (r & 63) * 32, (r >> 6) * 64, F.in[I_ANORM], scr, lane); continue; } r -= N_A;
        if (r < N_B) { const int k0 = (r >> 5) * 64, n0 = (r & 31) * 32;
            if (k0 < 512) p0_transpose_item(F.in[I_WOUT], 1024, k0, n0, (bf16*)(ws + WS_WOUTT), 1024, n0, k0, nullptr, scr, lane);
            else p0_transpose_item(F.in[I_WOUT], 1024, k0, n0, (bf16*)(ws + WS_WTMP), 512, n0, k0 - 512, nullptr, scr, lane);
            continue; } r -= N_B;
        if (r < N_C) { p0_transpose_item(F.in[I_WKV], 2048, (r >> 6) * 64, (r & 63) * 32, (bf16*)(ws + WS_WKVT), 1024, (r & 63) * 32, (r >> 6) * 64, nullptr, scr, lane); continue; } r -= N_C;
        if (r < N_D) { p0_transpose_item(F.in[I_WO], 1024, (r >> 5) * 64, (r & 31) * 32, (bf16*)(ws + WS_WOT), 1024, (r & 31) * 32, (r >> 5) * 64, nullptr, scr, lane); continue; } r -= N_D;
        if (r < N_H) { const int k = r >> 1, c0 = (r & 1) * 512 + lane * 8; const float g = F.in[I_CNORM][k]; const float* src = F.in[I_WQ] + (size_t)k * 1024 + c0;
            const f32x4 a = __builtin_nontemporal_load((const f32x4*)src) * g, b = __builtin_nontemporal_load((const f32x4*)(src + 4)) * g; u32x4 w; w.x = cvtpk(a[0], a[1]); w.y = cvtpk(a[2], a[3]); w.z = cvtpk(b[0], b[1]); w.w = cvtpk(b[2], b[3]);
            *(u32x4*)((bf16*)(ws + WS_WQN) + (size_t)k * 1024 + c0) = w; continue; } r -= N_H;
        if (r < N_I) { const int e0 = r * 512 + lane * 8;
            const float* pw = F.in[I_POOLW] + e0; const float* ps = F.in[I_POOLS] + (e0 >> 14) * 128 + (e0 & 127);
            const f32x4 a = *(const f32x4*)pw * *(const f32x4*)ps, b = *(const f32x4*)(pw + 4) * *(const f32x4*)(ps + 4);
            u32x4 w; w.x = cvtpk(a[0], a[1]); w.y = cvtpk(a[2], a[3]); w.z = cvtpk(b[0], b[1]); w.w = cvtpk(b[2], b[3]);
            *(u32x4*)((bf16*)(ws + WS_PWS) + e0) = w; continue; } r -= N_I;
        { const int idx = r * 64 + lane, j = idx >> 10, k = idx & 1023;
            float v = 0.f; if (j < 16) v = F.in[I_RE][((size_t)(j >> 2) * 1024 + k) * 4 + (j & 3)]; else if (j < 20) v = F.in[I_RG][(size_t)k * 4 + (j - 16)];
            v *= F.in[I_FNORM][k]; const unsigned hi = cvtpk(v, 0.f) & 0xffffu; const unsigned lo = cvtpk(v - bflo(hi), 0.f) & 0xffffu;
            ((bf16*)(ws + WS_WR))[idx] = (bf16)hi; ((bf16*)(ws + WS_WR + 65536))[idx] = (bf16)lo; }
    }
}

template <int W>
__device__ __forceinline__ void pool_unit_w(int b, int g, int xb, const bf16* Z, bf16* A2, int tid) {
    const int cv = tid & 15, rg = tid >> 4, t0 = xb * 128 + 4 * rg;
    const bf16* up = Z + ((size_t)b * SEQ + t0) * 2048 + 1536 + g * 128 + 8 * cv; bf16* op = A2 + ((size_t)b * SEQ + t0) * 1024 + 512 + g * 128 + 8 * cv;
    u32x4 x[W + 3];
#pragma unroll
    for (int i = 0; i < W + 3; ++i) { const int dt = i - (W - 1); x[i] = (t0 + dt >= 0) ? *(const u32x4*)(up + (long)dt * 2048) : (u32x4){0u, 0u, 0u, 0u}; }
    float s[8];
#pragma unroll
    for (int c = 0; c < 8; ++c) s[c] = 0.f;
#pragma unroll
    for (int i = 0; i < W; ++i)
#pragma unroll
        for (int c = 0; c < 4; ++c) { s[2 * c] += bflo(x[i][c]); s[2 * c + 1] += bfhi(x[i][c]); }
#pragma unroll
    for (int r = 0; r < 4; ++r) {
        const int cnt = (t0 + r + 1) < W ? (t0 + r + 1) : W; const float rc = 1.0f / (float)cnt;
        const u32x4 cur = x[W - 1 + r]; u32x4 o;
#pragma unroll
        for (int c = 0; c < 4; ++c) o[c] = cvtpk(s[2 * c] * rc - bflo(cur[c]), s[2 * c + 1] * rc - bfhi(cur[c]));
        st16(op + (size_t)r * 1024, o);
        if (r < 3) {
#pragma unroll
            for (int c = 0; c < 4; ++c) { s[2 * c] += bflo(x[W + r][c]) - bflo(x[r][c]); s[2 * c + 1] += bfhi(x[W + r][c]) - bfhi(x[r][c]); } }
    }
}
__device__ __forceinline__ void pool_unit(int b, int g, int xb, const bf16* Z, bf16* A2, int tid) {
    if (g == 0) pool_unit_w<2>(b, g, xb, Z, A2, tid); else if (g == 1) pool_unit_w<4>(b, g, xb, Z, A2, tid); else if (g == 2) pool_unit_w<8>(b, g, xb, Z, A2, tid); else pool_unit_w<16>(b, g, xb, Z, A2, tid);
}

__device__ __forceinline__ void moe_weight_items(Frame& F) {
    LAS float* scr = (LAS float*)(F.lds + RING_OFF + F.wave * 16384);
    const int gw = F.vcu * NWAVES + F.wave, NGW = F.G * NWAVES, lane = F.lane; unsigned char* ws = F.ws;
    for (int it0 = gw; it0 < 6144; it0 += 3 * NGW) {
        float v[3][32]; const float* W[3]; int ldw[3], k0[3], n0[3], ldt[3], drow[3]; bf16* WT[3]; const float* gain[3]; unsigned char* WT8[3];
#pragma unroll
        for (int j = 0; j < 3; ++j) { int r = it0 + j * NGW; if (r >= 6144) r = it0;
            if (r < 4096) { const int up = r >= 2048; if (up) r -= 2048; const int e = r >> 7, kb = (r >> 3) & 15, nb = r & 7; n0[j] = nb * 32; k0[j] = kb * 64;
                W[j] = F.in[up ? I_WU : I_WG] + (size_t)e * 1024 * 256; ldw[j] = 256; WT[j] = nullptr; ldt[j] = 1024; drow[j] = e * 512 + (n0[j] >> 7) * 256 + up * 128 + (n0[j] & 127); gain[j] = F.in[I_FNORM]; WT8[j] = ws + WS_WGUT8; }
            else { r -= 4096; const int e = r >> 7, kb = (r >> 5) & 3, nb = r & 31; n0[j] = nb * 32; k0[j] = kb * 64;
                W[j] = F.in[I_WD] + (size_t)e * 256 * 1024; ldw[j] = 1024; WT[j] = nullptr; ldt[j] = 256; drow[j] = n0[j]; gain[j] = nullptr; WT8[j] = ws + WS_WDT + (size_t)e * 1024 * 256; }
            p0_transpose_load(v[j], W[j], ldw[j], k0[j], n0[j], lane); }
#pragma unroll
        for (int j = 0; j < 3; ++j) if (it0 + j * NGW < 6144) p0_transpose_store(v[j], k0[j], WT[j], ldt[j], drow[j], k0[j], gain[j], scr, lane, WT8[j], 32.0f);
    }
}

__device__ __forceinline__ void p2_attention(Frame& F) {
    unsigned char* ws = F.ws; const bf16* Z = (const bf16*)(ws + WS_RB); bf16* A2 = (bf16*)(ws + WS_RA); const unsigned char* KT = ws + WS_RD;
    float lam; { const int l = F.lane; const float s1 = wave_sum(F.in[I_LQ1][l] * F.in[I_LK1][l]), s2 = wave_sum(F.in[I_LQ2][l] * F.in[I_LK2][l]); lam = __expf(s1) - __expf(s2) + 0.2f; }
    for (int p = F.vcu; p < 256; p += F.G) { const int bh = p >> 5, b = bh >> 2, h = bh & 3, s = p & 31;
#ifdef PROBE_ATT
        for (int j = 0; j < 4; ++j) { const int xb = (j & 1) ? s : 63 - s;
#else
        for (int j = 0; j < 2; ++j) { const int xb = j ? s : 63 - s;
#endif
            pool_unit(b, h, xb, Z, A2, F.tid);
#ifdef PROBE_POOL
            pool_unit(b, h, xb, Z, A2, F.tid);
#endif
#ifdef PROBE_ATTMODE
            dat::attn_unit<8, PROBE_ATTMODE>(b, h, xb, Z, KT, (bf16*)(F.ws + WS_RC), F.in[I_RELB], F.in[I_SUBLN], lam, (LAS char*)(F.lds + RING_OFF));
#endif
            dat::attn_unit<8>(b, h, xb, Z, KT, A2, F.in[I_RELB], F.in[I_SUBLN], lam, (LAS char*)(F.lds + RING_OFF));
            } }
    struct FoldJobs { const bf16* KVc; unsigned char* ws; int vcu, G;
        __device__ __forceinline__ TileJob operator()(int i) const { const int tI = vcu + i * G, t2 = tI & 511, bh = t2 >> 6, b = bh >> 2, hh = bh & 3, w = t2 & 63; TileJob j;
            if (tI < 512) { const int kt = w >> 4, kkt = w & 15;
                j.A = KVc + (size_t)(b * 256 + kt * 64) * 2048 + hh * 256; j.lda = 2048; j.B = (const bf16*)(ws + WS_WQN) + (size_t)(kkt * 64) * 1024 + hh * 256; j.ldb = 1024;
                j.C = (bf16*)(ws + WS_BTS + (size_t)b * 1024 * 1024 + (size_t)(hh * 256 + kt * 64) * 1024 + kkt * 64); j.ldc = 1024; j.c8 = 1; }
            else { const int nt = w >> 2, kt = w & 3;
                j.A = (const bf16*)(ws + WS_WOT) + (size_t)(nt * 64) * 1024 + hh * 256; j.lda = 1024; j.B = KVc + (size_t)(b * 256 + kt * 64) * 2048 + 1024 + hh * 256; j.ldb = 2048;
                j.C = (bf16*)(ws + WS_BTO + (size_t)b * 1024 * 1024 + (size_t)(nt * 64) * 1024 + hh * 256 + kt * 64); j.ldc = 1024; j.c8 = 1; }
            return j; } };
    const PlainJobs<FoldJobs> fj{FoldJobs{(const bf16*)(ws + WS_KVC), ws, F.vcu, F.G}};
    tile_pipe<256, 1>((LAS char*)(F.lds + RING_OFF), (1024 - F.vcu + F.G - 1) / F.G, fj, F.wave, F.lane);
    moe_weight_items(F);
}

struct RouteJobs { const bf16* H2; const bf16* WR; LAS float* lg; int chunk;
    __device__ __forceinline__ const bf16* arow(int, int row) const { return H2 + (size_t)(chunk * 64 + row) * 1024; }
    __device__ __forceinline__ const bf16* brow(int, int row) const { return WR + (size_t)(row & 31) * 1024; }
    __device__ __forceinline__ void store(int, int wave, int lane, f32x4 acc0, f32x4 acc1) const {
        if ((wave >> 2) == 0) { LAS float* p = lg + (16 * (wave & 3) + (lane & 15)) * 33 + 4 * (lane >> 4);
#pragma unroll
            for (int j = 0; j < 4; ++j) { p[j] = acc0[j]; p[16 + j] = acc1[j]; } } }
};
__device__ __forceinline__ void p6_route(Frame& F) {
    unsigned char* ws = F.ws; const float* SSQ2 = (const float*)(ws + WS_SSQ2);
    LAS int* lcnt = (LAS int*)(F.lds + LTAB_OFF); LAS int* gbase = lcnt + 16; LAS float* lg = (LAS float*)(F.lds + LTAB_OFF + 1024);
    if (F.tid < 16) lcnt[F.tid] = 0;
    for (int chunk = F.vcu; chunk < M / 64; chunk += F.G) {
        const RouteJobs rj{(const bf16*)(ws + WS_RA), (const bf16*)(ws + WS_WR), lg, chunk};
        tile_pipe<256, 4>((LAS char*)(F.lds + RING_OFF), 1, rj, F.wave, F.lane);
        bool emit = false; int e0 = 0, e1 = 0, p0 = 0, p1 = 0; const int tok = chunk * 64 + F.tid; float w0 = 0.f, w1 = 0.f, rs = 0.f;
        if (F.tid < 64) {
            { const f32x4* sp = (const f32x4*)(SSQ2 + (size_t)tok * 16); const f32x4 st = (sp[0] + sp[1]) + (sp[2] + sp[3]); rs = 1.0f / __builtin_sqrtf(((st[0] + st[1]) + (st[2] + st[3])) * (1.0f / 1024.0f) + EPS); }
            const LAS float* l = lg + F.tid * 33;
            float gl[4];
#pragma unroll
            for (int j = 0; j < 4; ++j) gl[j] = l[16 + j] * rs + F.in[I_RGB][j];
            int gs = 0; float gm = gl[0];
#pragma unroll
            for (int j = 1; j < 4; ++j) if (gl[j] > gm) { gm = gl[j]; gs = j; }
            float den = 0.f;
#pragma unroll
            for (int j = 0; j < 4; ++j) den += __expf(gl[j] - gm);
            const float gwt = 1.0f / den;
            float el[4];
#pragma unroll
            for (int j = 0; j < 4; ++j) el[j] = l[gs * 4 + j] * rs + F.in[I_REB][gs * 4 + j];
            int i0 = 0; float v0 = el[0];
#pragma unroll
            for (int j = 1; j < 4; ++j) if (el[j] > v0) { v0 = el[j]; i0 = j; }
            int i1 = -1; float v1 = -3.0e38f;
#pragma unroll
            for (int j = 0; j < 4; ++j) if (j != i0 && el[j] > v1) { v1 = el[j]; i1 = j; }
            const float t0 = 1.0f / (1.0f + __expf(v1 - v0));
            emit = true; e0 = gs * 4 + i0; e1 = gs * 4 + i1; w0 = gwt * t0; w1 = gwt * (1.0f - t0);
            p0 = atomicAdd((int*)(lcnt + e0), 1); p1 = atomicAdd((int*)(lcnt + e1), 1);
        }
        __syncthreads();
        if (F.tid < 16) gbase[F.tid] = (int)__hip_atomic_fetch_add(F.ctl + CW_CNT + 64 * F.tid, (unsigned)lcnt[F.tid], RLX_AGENT);
        __syncthreads();
        if (emit) { int* LIST = (int*)(ws + WS_LIST); float* LR = (float*)(ws + WS_LISTR); float* LW = (float*)(ws + WS_LISTW);
            const int i0 = e0 * 16384 + gbase[e0] + p0, i1 = e1 * 16384 + gbase[e1] + p1;
            LIST[i0] = tok * 2; LR[i0] = rs; LW[i0] = w0; LIST[i1] = tok * 2 + 1; LR[i1] = rs; LW[i1] = w1; }
        __syncthreads();
        if (F.tid < 16) lcnt[F.tid] = 0;
    }
}

__device__ __forceinline__ int moe_table(Frame& F) {
    LAS int* tab = (LAS int*)(F.lds + LTAB_OFF);
    __syncthreads();
    if (F.tid < 16) tab[32 + F.tid] = (int)__hip_atomic_load(F.ctl + CW_CNT + 64 * F.tid, RLX_AGENT);
    __syncthreads();
    if (F.tid == 0) { int p = 0, pf = 0, pt = 0; for (int e = 0; e < 16; ++e) { const int n = tab[32 + e]; tab[e] = p; tab[64 + e] = pf; tab[96 + e] = pt; p += (n + 255) >> 8; pf += n >> 8; pt += ((n & 255) + 63) >> 6; } tab[16] = p; tab[80] = pf; tab[112] = pt; }
    __syncthreads();
    return __builtin_amdgcn_readfirstlane(tab[80]);
}
struct TailBase { LAS const int* tab; int vcu, G, CT;
    __device__ __forceinline__ void decode(int i, int& e, int& r0, int& nv, int& ct) const {
        const int J = vcu + i * G, trow = J / CT; ct = J % CT; int ee = 0;
#pragma unroll
        for (int j = 1; j < 16; ++j) ee += (trow >= tab[96 + j]) ? 1 : 0;
        ee = __builtin_amdgcn_readfirstlane(ee); e = ee;
        const int n = __builtin_amdgcn_readfirstlane(tab[32 + ee]), ptt = __builtin_amdgcn_readfirstlane(tab[96 + ee]);
        r0 = (n >> 8) * 256 + (trow - ptt) * 64; nv = n - r0 < 64 ? n - r0 : 64;
    }
};
struct TailGateUp { TailBase tb; const bf16* H2b; const bf16* WguT; const int* list; const float* listr; const float* listw; unsigned char* ACT; float ascale;
    __device__ __forceinline__ const bf16* arow(int i, int lane) const { int e, r0, nv, ct; tb.decode(i, e, r0, nv, ct); const int tok = lane < nv ? (list[e * 16384 + r0 + lane] >> 1) : 0; return H2b + (size_t)tok * 512; }
    __device__ __forceinline__ const bf16* brow(int i, int lane) const { int e, r0, nv, ct; tb.decode(i, e, r0, nv, ct); const int c = ct * 32 + (lane >> 5) * 16 + (lane & 15), up = (lane >> 4) & 1;
        return WguT + (size_t)(e * 512 + (c >> 7) * 256 + up * 128 + (c & 127)) * 512; }
    __device__ __forceinline__ void store(int i, int wave, int lane, f32x4 acc0, f32x4 acc1) const { int e, r0, nv, ct; tb.decode(i, e, r0, nv, ct);
        const int row = 16 * (wave & 3) + (lane & 15); const bool ok = row < nv; const int li = e * 16384 + r0 + row;
        const float rs = ok ? listr[li] * ascale : 0.f, cw = ok ? listw[li] * 8.0f : 0.f; float a[4];
#pragma unroll
        for (int j = 0; j < 4; ++j) { const float g = acc0[j] * rs, up = acc1[j] * rs; a[j] = __builtin_amdgcn_fmed3f(g * __builtin_amdgcn_rcpf(1.0f + __builtin_amdgcn_exp2f(-g * LOG2E)) * up * cw, -448.0f, 448.0f); }
        *(GAS unsigned*)(ACT + (size_t)(tb.tab[e] * 256 + r0 + row) * 256 + ct * 32 + (wave >> 2) * 16 + 4 * (lane >> 4)) = pk4_fp8(a[0], a[1], a[2], a[3]); }
};
struct TailDown { TailBase tb; const bf16* ACT; const bf16* WdT; const int* list; unsigned char* YS; float ascale;
    __device__ __forceinline__ const bf16* arow(int i, int lane) const { int e, r0, nv, ct; tb.decode(i, e, r0, nv, ct); return ACT + (size_t)(tb.tab[e] * 256 + r0 + lane) * 128; }
    __device__ __forceinline__ const bf16* brow(int i, int lane) const { int e, r0, nv, ct; tb.decode(i, e, r0, nv, ct); return WdT + (size_t)e * 1024 * 128 + (size_t)(ct * 64 + lane) * 128; }
    __device__ __forceinline__ void store(int i, int wave, int lane, f32x4 acc0, f32x4 acc1) const { int e, r0, nv, ct; tb.decode(i, e, r0, nv, ct);
        const int row = 16 * (wave & 3) + (lane & 15);
        if (row < nv) { const unsigned v = (unsigned)list[e * 16384 + r0 + row]; unsigned char* cp = YS + ((size_t)(((v & 1u) << 14) + (v >> 1)) << 10) + ct * 64 + 32 * (wave >> 2) + 4 * (lane >> 4);
            acc0 *= ascale; acc1 *= ascale;
            *(GAS unsigned*)cp = pk4_fp8(__builtin_amdgcn_fmed3f(acc0[0], -448.f, 448.f), __builtin_amdgcn_fmed3f(acc0[1], -448.f, 448.f), __builtin_amdgcn_fmed3f(acc0[2], -448.f, 448.f), __builtin_amdgcn_fmed3f(acc0[3], -448.f, 448.f));
            *(GAS unsigned*)(cp + 16) = pk4_fp8(__builtin_amdgcn_fmed3f(acc1[0], -448.f, 448.f), __builtin_amdgcn_fmed3f(acc1[1], -448.f, 448.f), __builtin_amdgcn_fmed3f(acc1[2], -448.f, 448.f), __builtin_amdgcn_fmed3f(acc1[3], -448.f, 448.f)); } }
};

__device__ __forceinline__ void p9_final(Frame& F) {
    const int gw = F.vcu * NWAVES + F.wave, NGW = F.G * NWAVES, lane = F.lane; const unsigned char* YS = F.ws + WS_RB; const bf16* H2 = (const bf16*)(F.ws + WS_RA);
    const GAS f32x4* gr = (const GAS f32x4*)F.in[I_FINAL] + lane;
    for (int m0 = 2 * gw; m0 < M; m0 += 2 * NGW) {
        f32x4 v[2][4]; u32x2 hb[2][4]; unsigned a[2][4], c[2][4]; float s[2];
#pragma unroll
        for (int r = 0; r < 2; ++r) { const int m = m0 + r; const GAS u32x2* xr = (const GAS u32x2*)(H2 + (size_t)m * D) + lane;
            const GAS unsigned* y0 = (const GAS unsigned*)(YS + (size_t)m * D) + lane; const GAS unsigned* y1 = (const GAS unsigned*)(YS + ((size_t)M + m) * D) + lane;
#pragma unroll
            for (int j = 0; j < 4; ++j) { hb[r][j] = xr[64 * j]; a[r][j] = y0[64 * j]; c[r][j] = y1[64 * j]; } }
#pragma unroll
        for (int r = 0; r < 2; ++r) { s[r] = 0.f;
#pragma unroll
            for (int j = 0; j < 4; ++j) { const auto a01 = __builtin_amdgcn_cvt_pk_f32_fp8((int)a[r][j], false), a23 = __builtin_amdgcn_cvt_pk_f32_fp8((int)a[r][j], true), c01 = __builtin_amdgcn_cvt_pk_f32_fp8((int)c[r][j], false), c23 = __builtin_amdgcn_cvt_pk_f32_fp8((int)c[r][j], true);
                v[r][j].x = bflo(hb[r][j].x) + (a01[0] + c01[0]) * 0.0625f; v[r][j].y = bfhi(hb[r][j].x) + (a01[1] + c01[1]) * 0.0625f;
                v[r][j].z = bflo(hb[r][j].y) + (a23[0] + c23[0]) * 0.0625f; v[r][j].w = bfhi(hb[r][j].y) + (a23[1] + c23[1]) * 0.0625f;
                s[r] += (v[r][j].x * v[r][j].x + v[r][j].y * v[r][j].y) + (v[r][j].z * v[r][j].z + v[r][j].w * v[r][j].w); } }
#pragma unroll
        for (int r = 0; r < 2; ++r) { const float rstd = 1.f / __builtin_sqrtf(wave_sum(s[r]) * (1.f / D) + EPS); GAS f32x4* xo = (GAS f32x4*)(F.out + (size_t)(m0 + r) * D) + lane;
#pragma unroll
            for (int j = 0; j < 4; ++j) { const f32x4 g = gr[64 * j]; __builtin_nontemporal_store(v[r][j] * rstd * g, xo + 64 * j); } }
    }
}
struct Args { const float* in[27]; float* out; unsigned char* ws; int ph_lo, ph_hi, li, pad; };
__global__ void __launch_bounds__(NWAVES * 64, 2) hybrid_fwd(Args args) {
    extern __shared__ __attribute__((aligned(16))) unsigned char lds[];
    Frame F;
    F.lds = (LAS unsigned char*)lds;
    F.MISC = (volatile LAS unsigned*)(F.lds + MISC_OFF);
    F.tid = threadIdx.x; F.lane = F.tid & 63; F.wave = __builtin_amdgcn_readfirstlane(F.tid >> 6);
    F.G = gridDim.x; { const int bx = blockIdx.x; F.vcu = (F.G % 8 == 0) ? (bx % 8) * (F.G / 8) + bx / 8 : bx; }
    unsigned char* ws = args.ws; F.ws = ws; F.out = args.out;
#pragma unroll
    for (int i = 0; i < 27; ++i) F.in[i] = args.in[i];
    F.ctl = (gu32*)(ws + WS_CTL);
    for (int u = F.tid; u < (LDS_BYTES - LDSCTL_OFF) / 4; u += NWAVES * 64) ((LAS unsigned*)(F.lds + LDSCTL_OFF))[u] = 0u;
    __syncthreads();
    XcdBarrier bar = xcd_barrier_post((unsigned*)(F.ctl + CW_BAR) + args.li * XCD_BAR_WORDS, F.MISC + 8);
    if (threadIdx.x == 0) __hip_atomic_store((unsigned*)(F.ctl + CW_XCC) + F.vcu, 1u + bar.x, RLX_AGENT);
    const int lo = args.ph_lo, hi = args.ph_hi;
#ifndef PH_MASK
#define PH_MASK 0x3ff
#endif
#define IN(k) ((((PH_MASK) >> (k)) & 1) && lo <= (k) && (k) < hi)
#define BOTH(k) (IN(k) && IN((k) + 1))
#ifndef PROBE_MASK
#define PROBE_MASK 0
#endif
#define REP(k) (((PROBE_MASK) >> (k)) & 1)
#define GRID_BAR() xcd_barrier(bar)

    if (IN(0)) { p0_prologue(F); if (REP(0)) { GRID_BAR(); p0_prologue(F); } if (BOTH(0)) GRID_BAR(); }

    if (IN(1)) {
        {
            struct KvJobs { unsigned char* ws; int vcu, G;
                __device__ __forceinline__ TileJob operator()(int i) const { const int tI = vcu + i * G, rt = tI >> 5, ct = tI & 31; TileJob j;
                    j.A = (const bf16*)(ws + WS_MN) + (size_t)(rt * 64) * 1024; j.lda = 1024; j.B = (const bf16*)(ws + WS_WKVT) + (size_t)(ct * 64) * 1024; j.ldb = 1024;
                    j.C = (bf16*)(ws + WS_KVC) + (size_t)(rt * 64) * 2048 + ct * 64; j.ldc = 2048; j.c8 = 0; return j; } };
            const PlainJobs<KvJobs> kj{KvJobs{ws, F.vcu, F.G}};
            tile_pipe<256, 4>((LAS char*)(F.lds + RING_OFF), (256 - F.vcu + F.G - 1) / F.G, kj, F.wave, F.lane);
            struct PfJobs { unsigned char* ws; int vcu, G;
                __device__ __forceinline__ TileJob operator()(int i) const { const int tI = vcu + i * G, g = tI >> 5, nt = (tI >> 1) & 15, ct = tI & 1; TileJob j;
                    j.A = (const bf16*)(ws + WS_WTMP) + (size_t)(nt * 64) * 512 + g * 128; j.lda = 512; j.B = (const bf16*)(ws + WS_PWS) + (size_t)(g * 128 + ct * 64) * 128; j.ldb = 128;
                    j.C = (bf16*)(ws + WS_WOUTT) + (size_t)(nt * 64) * 1024 + 512 + g * 128 + ct * 64; j.ldc = 1024; j.c8 = 0; return j; } };
            const PlainJobs<PfJobs> pj{PfJobs{ws, F.vcu, F.G}};
            tile_pipe<128, 1>((LAS char*)(F.lds + RING_OFF), F.vcu < 128 ? (128 - F.vcu + F.G - 1) / F.G : 0, pj, F.wave, F.lane);
        }
        pg8::DenseOrder S; S.init(ws + WS_XB, ws + WS_WINT, M, 2048, D, 0, F.G, (int)blockIdx.x);
        pg8::EpiZ E{(bf16*)(ws + WS_RB), ws + WS_RD, C2, (const float*)(ws + WS_RSX), F.lds + 131072};
        pg8::gemm_phase<pg8::EpiZ, pg8::DenseOrder, true>(F.lds + RING_OFF, D, S, E); if (REP(1)) { GRID_BAR(); pg8::gemm_phase<pg8::EpiZ, pg8::DenseOrder, true>(F.lds + RING_OFF, D, S, E); }
        if (BOTH(1)) GRID_BAR();
    }

    if (IN(2)) { p2_attention(F);
        if (REP(2)) { GRID_BAR(); p2_attention(F); }
        if (BOTH(2)) GRID_BAR(); }

    const bool panel = (PROBE_MASK) == 0 && F.G == 256 && BOTH(3) && BOTH(4) && BOTH(5);
    unsigned* const pcnt = (unsigned*)(F.ctl + CW_PAN); unsigned* const ptmo = (unsigned*)(F.ctl + CW_BAR) + args.li * XCD_BAR_WORDS + XB_TMO;
    int mypm = 0; bool plocal = false;
    if (panel) { pg8::DenseOrder S0; S0.init(ws, ws, M, D, D, 0, F.G, (int)blockIdx.x); pg8::Unit u0; S0.next(0, u0); mypm = u0.pm;
        unsigned same = 1u; const unsigned me = 1u + bar.x;
#pragma unroll
        for (int j = 0; j < 4; ++j) { same &= (xb_ld((unsigned*)(F.ctl + CW_XCC) + 32 * (mypm >> 3) + 8 * j + (mypm & 7)) == me) ? 1u : 0u; same &= (xb_ld((unsigned*)(F.ctl + CW_XCC) + 4 * mypm + j) == me) ? 1u : 0u; }
        plocal = __builtin_amdgcn_readfirstlane((int)same) != 0; }

    if (IN(3)) {
        pg8::DenseOrder S; S.init(ws + WS_RA, ws + WS_WOUTT, M, D, D, 0, F.G, (int)blockIdx.x);
        pg8::EpiRes<true, true> E{(const bf16*)(ws + WS_XB), (bf16*)(ws + WS_RC), (float*)(ws + WS_SSQ1), ws + WS_RD + 16 * MiB, 1.0f};
        pg8::gemm_phase<pg8::EpiRes<true, true>, pg8::DenseOrder, true>(F.lds + RING_OFF, D, S, E); if (REP(3)) { GRID_BAR(); pg8::gemm_phase<pg8::EpiRes<true, true>, pg8::DenseOrder, true>(F.lds + RING_OFF, D, S, E); }
        if (panel) { panel_signal(pcnt + (0 * 64 + mypm) * 16, plocal); panel_wait(pcnt + (0 * 64 + mypm) * 16, 4u, ptmo); } else if (BOTH(3)) GRID_BAR();
    }

    if (IN(4)) {
        pg8::DenseOrder S; S.init(ws + WS_RD + 16 * MiB, ws + WS_BTS, M, D, D / 2, (size_t)1024 * 1024, F.G, (int)blockIdx.x);
        pg8::EpiSoftmax E{(const float*)(ws + WS_SSQ1), ws + WS_RD};
        pg8::gemm_phase<pg8::EpiSoftmax, pg8::DenseOrder, false, true>(F.lds + RING_OFF, D / 2, S, E); if (REP(4)) { GRID_BAR(); pg8::gemm_phase<pg8::EpiSoftmax, pg8::DenseOrder, false, true>(F.lds + RING_OFF, D / 2, S, E); }
        if (panel) { panel_signal(pcnt + (1 * 64 + mypm) * 16, plocal); panel_wait(pcnt + (1 * 64 + mypm) * 16, 4u, ptmo); } else if (BOTH(4)) GRID_BAR();
    }

    if (IN(5)) {
        pg8::DenseOrder S; S.init(ws + WS_RD, ws + WS_BTO, M, D, D / 2, (size_t)1024 * 1024, F.G, (int)blockIdx.x);
        pg8::EpiRes<true, true> E{(const bf16*)(ws + WS_RC), (bf16*)(ws + WS_RA), (float*)(ws + WS_SSQ2), ws + WS_RD + 16 * MiB, 1.0f / 256.0f};
        pg8::gemm_phase<pg8::EpiRes<true, true>, pg8::DenseOrder, true, true>(F.lds + RING_OFF, D / 2, S, E); if (REP(5)) { GRID_BAR(); pg8::gemm_phase<pg8::EpiRes<true, true>, pg8::DenseOrder, true, true>(F.lds + RING_OFF, D / 2, S, E); }
        if (panel) { panel_signal(pcnt + (2 * 64 + mypm) * 16, plocal); panel_wait(pcnt + (2 * 64 + (F.vcu >> 2)) * 16, 4u, ptmo); } else if (BOTH(5)) GRID_BAR();
    }

    if (IN(6)) { p6_route(F); if (BOTH(6)) GRID_BAR(); }

    if (IN(7)) {
        const int nft = moe_table(F); LAS const int* tab = (LAS const int*)(F.lds + LTAB_OFF);
        { const int ntt = __builtin_amdgcn_readfirstlane(tab[112]) * 8;
          const TailGateUp tj{TailBase{tab, F.vcu, F.G, 8}, (const bf16*)(ws + WS_RD + 16 * MiB), (const bf16*)(ws + WS_WGUT8), (const int*)(ws + WS_LIST), (const float*)(ws + WS_LISTR), (const float*)(ws + WS_LISTW), ws + WS_RC, 1.0f / 32.0f};
          tile_pipe<256, 2, true>((LAS char*)(F.lds + RING_OFF), F.vcu < ntt ? (ntt - F.vcu + F.G - 1) / F.G : 0, tj, F.wave, F.lane); }
        pg8::MoeOrder<2, true> S{tab, (const char*)(ws + WS_RD + 16 * MiB), (const char*)(ws + WS_WGUT8), (const int*)(ws + WS_LIST), F.G, F.vcu, nft * 2, (size_t)512 * 1024, (size_t)256 * 1024};
        pg8::EpiGateUp E{ws + WS_RC, (const float*)(ws + WS_LISTR), (const float*)(ws + WS_LISTW), 1.0f / 32.0f};
        pg8::gemm_phase<pg8::EpiGateUp, pg8::MoeOrder<2, true>, true, true>(F.lds + RING_OFF, D / 2, S, E);
        if (REP(7)) { GRID_BAR(); pg8::gemm_phase<pg8::EpiGateUp, pg8::MoeOrder<2, true>, true, true>(F.lds + RING_OFF, D / 2, S, E); }
        if (REP(10)) { GRID_BAR(); const int ntt = __builtin_amdgcn_readfirstlane(tab[112]) * 8;
          const TailGateUp tj{TailBase{tab, F.vcu, F.G, 8}, (const bf16*)(ws + WS_RD + 16 * MiB), (const bf16*)(ws + WS_WGUT8), (const int*)(ws + WS_LIST), (const float*)(ws + WS_LISTR), (const float*)(ws + WS_LISTW), ws + WS_RC, 1.0f / 32.0f};
          tile_pipe<256, 2, true>((LAS char*)(F.lds + RING_OFF), F.vcu < ntt ? (ntt - F.vcu + F.G - 1) / F.G : 0, tj, F.wave, F.lane); }
        if (BOTH(7)) GRID_BAR();
    }

    if (IN(8)) {
        LAS const int* tab = (LAS const int*)(F.lds + LTAB_OFF);
        const int nft = IN(7) ? __builtin_amdgcn_readfirstlane(tab[80]) : moe_table(F);
        { const int ntt = __builtin_amdgcn_readfirstlane(tab[112]) * 16;
          const TailDown tj{TailBase{tab, F.vcu, F.G, 16}, (const bf16*)(ws + WS_RC), (const bf16*)(ws + WS_WDT), (const int*)(ws + WS_LIST), ws + WS_RB, 1.0f / 16.0f};
          tile_pipe<128, 1, true>((LAS char*)(F.lds + RING_OFF), F.vcu < ntt ? (ntt - F.vcu + F.G - 1) / F.G : 0, tj, F.wave, F.lane); }
        pg8::MoeOrder<4, false> S{tab, (const char*)(ws + WS_RC), (const char*)(ws + WS_WDT), (const int*)(ws + WS_LIST), F.G, F.vcu, nft * 4, (size_t)1024 * 256, (size_t)256 * 256, (size_t)FF};
        pg8::EpiDown E{ws + WS_RB, (const int*)(ws + WS_LIST), 1.0f / 16.0f};
        pg8::gemm_phase<pg8::EpiDown, pg8::MoeOrder<4, false>, true, true>(F.lds + RING_OFF, FF / 2, S, E);
        if (REP(8)) { GRID_BAR(); pg8::gemm_phase<pg8::EpiDown, pg8::MoeOrder<4, false>, true, true>(F.lds + RING_OFF, FF / 2, S, E); }
        if (BOTH(8)) GRID_BAR();
    }

    if (IN(9)) { p9_final(F); if (REP(9)) { GRID_BAR(); p9_final(F); } }
#undef IN
#undef BOTH
#undef GRID_BAR
}

extern "C" void kernel_launch(void* const* d_in, const int* in_sizes, int n_in, void* d_out, int out_size, void* d_ws, size_t ws_size, hipStream_t stream) {
    static int grid = 0;
    if (grid == 0) {
        if (n_in != 27 || in_sizes[0] != M * D || out_size != M * D || ws_size < WS_END) { fprintf(stderr, "kernel_launch: unexpected problem shape (n_in %d, in0 %d, out %d, ws %zu); nothing launched\n", n_in, n_in > 0 ? in_sizes[0] : -1, out_size, ws_size); grid = -1; return; }
        int dev = 0, cus = 0, per_cu = 0;
        if (hipGetDevice(&dev) != hipSuccess || hipDeviceGetAttribute(&cus, hipDeviceAttributeMultiprocessorCount, dev) != hipSuccess) { grid = -1; return; }
        if (hipFuncSetAttribute((const void*)hybrid_fwd, hipFuncAttributeMaxDynamicSharedMemorySize, LDS_BYTES) != hipSuccess) { fprintf(stderr, "kernel_launch: hipFuncSetAttribute failed\n"); grid = -1; return; }
        if (hipOccupancyMaxActiveBlocksPerMultiprocessor(&per_cu, (const void*)hybrid_fwd, NWAVES * 64, LDS_BYTES) != hipSuccess || per_cu < 1) { fprintf(stderr, "kernel_launch: occupancy query reports %d workgroups per CU\n", per_cu); }
        (void)hipGetLastError();
        grid = cus < 256 ? cus : 256;
        if (grid != 256) fprintf(stderr, "kernel_launch: %d CUs: the single-unit GEMM phases assume 256 workgroups\n", grid);
    }
    if (grid < 0) return;
    if (hipMemsetAsync((char*)d_ws + WS_CTL, 0, CTL_ZERO_BYTES, stream) != hipSuccess) return;
    Args a{};
    for (int i = 0; i < 27; ++i) a.in[i] = (const float*)d_in[i];
    a.out = (float*)d_out; a.ws = (unsigned char*)d_ws; a.pad = 0;
    constexpr int NL = MK_N_LAUNCHES;
    for (int li = 0; li < NL; ++li) {
        a.ph_lo = (NL == 1) ? 0 : li; a.ph_hi = (NL == 1) ? N_PHASES : li + 1; a.li = li;
        hipLaunchKernelGGL(hybrid_fwd, dim3(grid), dim3(NWAVES * 64), LDS_BYTES, stream, a);
    }
}
```

```cpp
#include <hip/hip_runtime.h>
#include <cstdio>
#include <cstdint>

#define GAS __attribute__((address_space(1)))
#define LAS __attribute__((address_space(3)))
typedef unsigned short bf16;
typedef short bf16x8 __attribute__((ext_vector_type(8)));
typedef float f32x4 __attribute__((ext_vector_type(4)));
typedef float f32x2 __attribute__((ext_vector_type(2)));
typedef float f32x16 __attribute__((ext_vector_type(16)));
typedef unsigned u32x4 __attribute__((ext_vector_type(4)));
typedef unsigned u32x2 __attribute__((ext_vector_type(2)));
typedef __bf16 bf16x2_t __attribute__((ext_vector_type(2)));

__device__ __forceinline__ unsigned cvtpk(float lo, float hi) { f32x2 v = {lo, hi}; bf16x2_t b = __builtin_convertvector(v, bf16x2_t); return __builtin_bit_cast(unsigned, b); }
__device__ __forceinline__ float bf2f(unsigned short b) { return __builtin_bit_cast(float, (unsigned)b << 16); }
__device__ __forceinline__ float bflo(unsigned w) { return __builtin_bit_cast(float, w << 16); }
__device__ __forceinline__ float bfhi(unsigned w) { return __builtin_bit_cast(float, w & 0xffff0000u); }

__device__ __forceinline__ unsigned pk4_fp8(float a, float b, float c, float d) { int w = 0; w = __builtin_amdgcn_cvt_pk_fp8_f32(a, b, w, false); w = __builtin_amdgcn_cvt_pk_fp8_f32(c, d, w, true); return (unsigned)w; }
typedef int v8i32 __attribute__((ext_vector_type(8))); typedef int v4i32 __attribute__((ext_vector_type(4)));

#ifndef WT_STORES
#define WT_STORES 0
#endif
__device__ __forceinline__ void st16(void* p, u32x4 v) {
#if WT_STORES
    asm volatile("global_store_dwordx4 %0, %1, off sc1\n\ts_nop 1" :: "v"(p), "v"(v) : "memory");
#else
    *(u32x4*)p = v;
#endif
}
__device__ __forceinline__ void st8(void* p, u32x2 v) {
#if WT_STORES
    asm volatile("global_store_dwordx2 %0, %1, off sc1\n\ts_nop 1" :: "v"(p), "v"(v) : "memory");
#else
    *(u32x2*)p = v;
#endif
}

namespace pg8 {
constexpr int BM = 256, BK = 64, HALF = 128, HTB = HALF * BK * 2  , STAGE_BYTES = 8 * HTB, NXCD = 8, WGM = 8;

__host__ __device__ __forceinline__ int lds_byte(int r, int c) { const int st = (r >> 4) * 2 + (c >> 5), rr = r & 15, cc = c & 31, ob = rr * 64 + cc * 2; return st * 1024 + (ob ^ (((ob >> 9) & 1) << 5)); }
__host__ __device__ __forceinline__ void stage_rc(int b, int& R, int& C) { const int st = b / 1024, sb = b % 1024, swz = sb ^ (((sb >> 9) & 1) << 5); R = (st >> 1) * 16 + swz / 64; C = (st & 1) * 32 + (swz % 64) / 2; }
__host__ __device__ __forceinline__ int perm32(int rho) { const int n = rho >> 4, i = rho & 15; return 8 * (i >> 2) + 4 * n + (i & 3); }

struct Unit { int pm, pn, e, row0, nval, lofs; };

template <class Epi, class Sched, bool ALIGN_EPI, bool F8 = false>
__device__ __forceinline__ void gemm_phase(LAS unsigned char* lds, const int K, const Sched& S, const Epi& E) {
    const int tid = threadIdx.x, wid = __builtin_amdgcn_readfirstlane(tid >> 6), lane = tid & 63, wr = wid >> 2, wc = wid & 3, fr = lane & 15, fq = lane >> 4;
    const int nt = K / BK;
    int Rl[2], Cl[2];
    unsigned voffA[2][2], voffAn[2][2], voffB[2][2];
#pragma unroll
    for (int i = 0; i < 2; ++i) { int R, C; stage_rc(tid * 16 + i * 8192, R, C); Rl[i] = R; Cl[i] = C; const int Rb = Epi::PERM ? ((R & ~31) + perm32(R & 31)) : R;
#pragma unroll
        for (int h = 0; h < 2; ++h) { voffB[h][i] = (unsigned)((Rb + HALF * h) * K + C) * 2u; voffA[h][i] = (unsigned)((R + HALF * h) * K + C) * 2u; voffAn[h][i] = voffA[h][i]; } }
    const size_t kstep = (size_t)(BK * 2);
    const unsigned ldsw = (unsigned)wid * 1024u;
    const int aoff = lds_byte(wr * 64 + fr, fq * 8), boff = lds_byte(wc * 32 + fr, fq * 8);
#define PG8_SA(b, h) (((b) * 2 + (h)) * HTB)
#define PG8_SB(b, h) ((4 + (b) * 2 + (h)) * HTB)
#define PG8_STAGE(bufoff, gbase, voff) do { _Pragma("unroll") for (int _i = 0; _i < 2; ++_i) \
        __builtin_amdgcn_global_load_lds((const unsigned*)((const char*)(gbase) + (voff)[_i]), (LAS unsigned*)(lds + (bufoff) + ldsw + _i * 8192), 16, 0, 0); } while (0)
#define PG8_LDA(dst, b, h) do { _Pragma("unroll") for (int m = 0; m < 4; ++m) { dst[m].lo = *(const LAS v4i32*)(lds + PG8_SA(b, h) + aoff + m * 2048); dst[m].hi = *(const LAS v4i32*)(lds + PG8_SA(b, h) + aoff + m * 2048 + 1024); } } while (0)
#define PG8_LDB(dst, b, h) do { _Pragma("unroll") for (int n = 0; n < 2; ++n) { dst[n].lo = *(const LAS v4i32*)(lds + PG8_SB(b, h) + boff + n * 2048); dst[n].hi = *(const LAS v4i32*)(lds + PG8_SB(b, h) + boff + n * 2048 + 1024); } } while (0)
#define PG8_CAT(x) __builtin_shufflevector((x).lo, (x).hi, 0, 1, 2, 3, 4, 5, 6, 7)
#define PG8_MMA(ai, bj, At, Bt) do { __builtin_amdgcn_s_setprio(1); _Pragma("unroll") for (int m = 0; m < 4; ++m) _Pragma("unroll") for (int n = 0; n < 2; ++n) { \
        if constexpr (F8) { const v8i32 b8_ = PG8_CAT(Bt[n]), a8_ = PG8_CAT(At[m]); asm volatile("v_mfma_f32_16x16x128_f8f6f4 %0, %1, %2, %0" : "+v"(acc[ai][bj][m][n]) : "v"(b8_), "v"(a8_)); } \
        else { acc[ai][bj][m][n] = __builtin_amdgcn_mfma_f32_16x16x32_bf16(__builtin_bit_cast(bf16x8, Bt[n].lo), __builtin_bit_cast(bf16x8, At[m].lo), acc[ai][bj][m][n], 0, 0, 0); \
               acc[ai][bj][m][n] = __builtin_amdgcn_mfma_f32_16x16x32_bf16(__builtin_bit_cast(bf16x8, Bt[n].hi), __builtin_bit_cast(bf16x8, At[m].hi), acc[ai][bj][m][n], 0, 0, 0); } } \
        __builtin_amdgcn_s_setprio(0); } while (0)
#define PG8_WAIT_V(n) asm volatile("s_waitcnt vmcnt(" #n ")" ::: "memory")
#define PG8_WAIT_L(n) asm volatile("s_waitcnt lgkmcnt(" #n ")" ::: "memory")
#define PG8_BAR __builtin_amdgcn_s_barrier()
#define PG8_SCHED __builtin_amdgcn_sched_barrier(0)
    Unit cur, nxt; int ui = 0;
    if (!S.next(0, cur)) return;
    if constexpr (Sched::GATHER) S.gather(cur, Rl, Cl, K, voffA);
    f32x4 acc[2][2][4][2];
#pragma unroll
    for (int a = 0; a < 2; ++a)
#pragma unroll
        for (int b = 0; b < 2; ++b)
#pragma unroll
            for (int m = 0; m < 4; ++m)
#pragma unroll
                for (int n = 0; n < 2; ++n) acc[a][b][m][n] = (f32x4){0.f, 0.f, 0.f, 0.f};
    struct Frag { v4i32 lo, hi; }; Frag At[4], B0[2], B1[2];
    const char* cA = S.a_base(cur); const char* cB = S.b_base(cur);
    PG8_STAGE(PG8_SB(0, 0), cB, voffB[0]); PG8_STAGE(PG8_SB(0, 1), cB, voffB[1]); PG8_STAGE(PG8_SA(0, 0), cA, voffA[0]); PG8_STAGE(PG8_SA(0, 1), cA, voffA[1]);
    if (wr == 1) PG8_BAR;
    PG8_WAIT_V(2); PG8_BAR;
    PG8_STAGE(PG8_SB(1, 0), cB + kstep, voffB[0]); PG8_STAGE(PG8_SA(1, 0), cA + kstep, voffA[0]); PG8_STAGE(PG8_SB(1, 1), cB + kstep, voffB[1]);
    PG8_WAIT_V(6); PG8_BAR;
    for (;;) {
        const bool has_next = S.next(ui + 1, nxt);
        const char* nA = has_next ? S.a_base(nxt) : cA; const char* nB = has_next ? S.b_base(nxt) : cB;
        if constexpr (Sched::GATHER) { if (has_next) S.gather(nxt, Rl, Cl, K, voffAn); else {
#pragma unroll
            for (int h = 0; h < 2; ++h)
#pragma unroll
                for (int i = 0; i < 2; ++i) voffAn[h][i] = voffA[h][i]; } }
#pragma clang loop unroll(disable)
        for (int t = 0; t < nt; t += 2) {
            const bool last = (t == nt - 2);
            const char* a1 = cA + (size_t)(t + 1) * kstep;
            const char* a2 = last ? nA : cA + (size_t)(t + 2) * kstep; const char* b2 = last ? nB : cB + (size_t)(t + 2) * kstep;
            const char* a3 = a2 + kstep; const char* b3 = b2 + kstep;
            unsigned vA2[2][2];
#pragma unroll
            for (int h = 0; h < 2; ++h)
#pragma unroll
                for (int i = 0; i < 2; ++i) vA2[h][i] = (Sched::GATHER && last) ? voffAn[h][i] : voffA[h][i];
            PG8_LDB(B0, 0, 0); PG8_LDB(B1, 0, 1); PG8_SCHED; PG8_LDA(At, 0, 0); PG8_STAGE(PG8_SA(1, 1), a1, voffA[1]);
            PG8_WAIT_V(8); PG8_WAIT_L(0); PG8_BAR; PG8_MMA(0, 0, At, B0); PG8_MMA(0, 1, At, B1); PG8_BAR; PG8_SCHED;
            PG8_LDA(At, 0, 1); PG8_STAGE(PG8_SB(0, 0), b2, voffB[0]); PG8_STAGE(PG8_SB(0, 1), b2, voffB[1]); PG8_STAGE(PG8_SA(0, 0), a2, vA2[0]);
            PG8_WAIT_V(8); PG8_WAIT_L(0); PG8_BAR; PG8_MMA(1, 0, At, B0); PG8_MMA(1, 1, At, B1); PG8_BAR; PG8_SCHED;
            PG8_LDB(B0, 1, 0); PG8_LDB(B1, 1, 1); PG8_SCHED; PG8_LDA(At, 1, 0); PG8_STAGE(PG8_SA(0, 1), a2, vA2[1]);
            PG8_WAIT_V(8); PG8_WAIT_L(0); PG8_BAR; PG8_MMA(0, 0, At, B0); PG8_MMA(0, 1, At, B1); PG8_BAR; PG8_SCHED;
            PG8_LDA(At, 1, 1); PG8_STAGE(PG8_SB(1, 0), b3, voffB[0]); PG8_STAGE(PG8_SB(1, 1), b3, voffB[1]); PG8_STAGE(PG8_SA(1, 0), a3, vA2[0]);
            PG8_WAIT_V(8); PG8_WAIT_L(0); PG8_BAR; PG8_MMA(1, 0, At, B0); PG8_MMA(1, 1, At, B1); PG8_BAR; PG8_SCHED;
        }
        if constexpr (ALIGN_EPI) { if (wr == 0) PG8_BAR; }
        if constexpr (!Epi::AFTER_DRAIN) { E(acc, cur, wr, wc, fr, fq); }
        if (!has_next) break;
#pragma unroll
        for (int a = 0; a < 2; ++a)
#pragma unroll
            for (int b = 0; b < 2; ++b)
#pragma unroll
                for (int m = 0; m < 4; ++m)
#pragma unroll
                    for (int n = 0; n < 2; ++n) acc[a][b][m][n] = (f32x4){0.f, 0.f, 0.f, 0.f};
        cur = nxt; cA = nA; cB = nB; ++ui;
        if constexpr (Sched::GATHER) {
#pragma unroll
            for (int h = 0; h < 2; ++h)
#pragma unroll
                for (int i = 0; i < 2; ++i) voffA[h][i] = voffAn[h][i]; }
        if constexpr (ALIGN_EPI) { if (wr == 1) PG8_BAR; }
    }
    PG8_WAIT_V(0);
    if constexpr (!ALIGN_EPI) { if (wr == 0) PG8_BAR; }
    PG8_BAR;
    if constexpr (Epi::AFTER_DRAIN) { E.fused(acc, cur, wr, wc, fr, fq, lds, wid, lane); }
#undef PG8_SA
#undef PG8_SB
#undef PG8_STAGE
#undef PG8_LDA
#undef PG8_LDB
#undef PG8_MMA
#undef PG8_WAIT_V
#undef PG8_WAIT_L
#undef PG8_BAR
#undef PG8_SCHED
}

struct DenseOrder {
    static constexpr bool GATHER = false;
    const char* A; const char* B; int K; size_t bbatch; int nM, nN, nwg, G, c;
    __device__ void init(const void* A_, const void* B_, int M, int N, int K_, size_t bbatch_, int G_, int c_) { A = (const char*)A_; B = (const char*)B_; K = K_; bbatch = bbatch_; nM = M / BM; nN = N / BM; nwg = nM * nN; G = G_; c = c_; }
    __device__ __forceinline__ bool next(int i, Unit& u) const {
        const long L = (long)i * G + c; if (L >= nwg) return false;
        int wgid = (int)L; { const int q = nwg / NXCD, r = nwg % NXCD, xcd = wgid % NXCD, off = wgid / NXCD; wgid = (xcd < r ? xcd * (q + 1) : r * (q + 1) + (xcd - r) * q) + off; }
        const int nig = WGM * nN, gid = wgid / nig, fm = gid * WGM, gsz = (nM - fm) < WGM ? (nM - fm) : WGM;
        u.pm = fm + ((wgid % nig) % gsz); u.pn = (wgid % nig) / gsz; u.e = 0; u.row0 = 0; u.nval = 256; u.lofs = 0; return true;
    }
    __device__ __forceinline__ const char* a_base(const Unit& u) const { return A + (size_t)u.pm * ((size_t)BM * K * 2); }
    __device__ __forceinline__ const char* b_base(const Unit& u) const { return B + (u.pm >= 32 ? bbatch : (size_t)0) + (size_t)u.pn * ((size_t)BM * K * 2); }
    __device__ __forceinline__ void gather(const Unit&, const int (&)[2], const int (&)[2], int, unsigned (&)[2][2]) const {}
};
}
namespace dat {
constexpr int SEQ = 8192, ZP = 2048;
constexpr int KSLOT = 8192, VSLOT = 8192, NKS = 8, NVS = 8, L_V = NKS * KSLOT, L_TAB = L_V + NVS * VSLOT, LDS_BYTES = L_TAB + 1024;
constexpr int KT_BLOCK = 16384;
constexpr float LOG2E = 1.4426950408889634f;
__device__ __forceinline__ void glds16(const void* gsrc, unsigned lds_dst) { unsigned keep;
    asm volatile("s_mov_b32 %0, m0\n\ts_mov_b32 m0, %2\n\ts_nop 0\n\tglobal_load_lds_dwordx4 %1, off\n\ts_mov_b32 m0, %0" : "=&s"(keep) : "v"(gsrc), "s"(lds_dst) : "memory"); }
#define DAT_WAIT_BAR(N) asm volatile("s_waitcnt vmcnt(" #N ") lgkmcnt(0)\n\ts_barrier" ::: "memory")
#define DAT_SB() __builtin_amdgcn_sched_barrier(0)
typedef short v4i16_t __attribute__((ext_vector_type(4)));
typedef short s16x4 __attribute__((ext_vector_type(4)));
__device__ __forceinline__ s16x4 vtr(LAS const char* p) { return __builtin_bit_cast(s16x4, __builtin_amdgcn_ds_read_tr16_b64_v4i16((LAS v4i16_t*)p)); }
__device__ __forceinline__ float max3f(float a, float b, float c) { float r; asm("v_max3_f32 %0, %1, %2, %3" : "=v"(r) : "v"(a), "v"(b), "v"(c)); return r; }
__device__ __forceinline__ float max2f(float a, float b) { float r; asm("v_max_f32_e32 %0, %1, %2" : "=v"(r) : "v"(a), "v"(b)); return r; }

__device__ __forceinline__ int rel_bucket(int rel) {
    const int n = rel < 0 ? -rel : rel; int b = rel > 0 ? 16 : 0;
    int l = n < 8 ? n : (n >= 91 ? 15 : n >= 64 ? 14 : n >= 46 ? 13 : n >= 32 ? 12 : n >= 23 ? 11 : n >= 16 ? 10 : n >= 12 ? 9 : 8);
    return b + l;
}

struct VFrag { v4i32 lo, hi; };
__device__ __forceinline__ void vread(VFrag& v, LAS const char* vp, int d) { v.lo = *(LAS const v4i32*)(vp + d * 2048); v.hi = *(LAS const v4i32*)(vp + d * 2048 + 16); }
template <bool SKIP = false>
__device__ __forceinline__ void pvmma(f32x16& o, const VFrag& v, const v8i32& pf) {
    if (SKIP) return;
    o = __builtin_amdgcn_mfma_scale_f32_32x32x64_f8f6f4(__builtin_shufflevector(v.lo, v.hi, 0, 1, 2, 3, 4, 5, 6, 7), pf, o, 0, 0, 0, 0, 0, 0);
}
__device__ __forceinline__ void kread(VFrag (&kf)[2], LAS const char* kp) {
#pragma unroll
    for (int j = 0; j < 2; ++j) { kf[j].lo = *(LAS const v4i32*)(kp + j * 512); kf[j].hi = *(LAS const v4i32*)(kp + 1024 + j * 512); }
}
template <bool COMP>
__device__ __forceinline__ void qkmma(f32x16& p0, f32x16& p1, const VFrag (&kf)[2], const v8i32& qf, const v8i32& ql, const f32x16& negm) {
    const v8i32 k0 = __builtin_shufflevector(kf[0].lo, kf[0].hi, 0, 1, 2, 3, 4, 5, 6, 7), k1 = __builtin_shufflevector(kf[1].lo, kf[1].hi, 0, 1, 2, 3, 4, 5, 6, 7);
    p0 = __builtin_amdgcn_mfma_scale_f32_32x32x64_f8f6f4(k0, qf, negm, 0, 0, 0, 0, 0, 0);
    p1 = __builtin_amdgcn_mfma_scale_f32_32x32x64_f8f6f4(k1, qf, negm, 0, 0, 0, 0, 0, 0);
    if constexpr (COMP) { p0 = __builtin_amdgcn_mfma_scale_f32_32x32x64_f8f6f4(k0, ql, p0, 0, 0, 0, 0, 0, 0); p1 = __builtin_amdgcn_mfma_scale_f32_32x32x64_f8f6f4(k1, ql, p1, 0, 0, 0, 0, 0, 0); }
}
template <int THRL>
__device__ __forceinline__ void softmax_max(bool first, f32x16& p0, f32x16& p1, f32x16& negm, float& mrun, f32x16& ol, f32x16 (&o)[4], bool near, int ib, LAS const float* tab) {
    if (near) {
#pragma unroll
        for (int r = 0; r < 16; ++r) { const int kk = (r & 3) + 8 * (r >> 2); p0[r] += tab[ib + kk]; p1[r] += tab[ib + kk + 32]; }
    }
    float ma = max3f(p0[0], p0[1], p0[2]), mb = max3f(p1[0], p1[1], p1[2]);
    ma = max3f(ma, p0[3], p0[4]); mb = max3f(mb, p1[3], p1[4]);
#pragma unroll
    for (int r = 5; r < 15; r += 2) { ma = max3f(ma, p0[r], p0[r + 1]); mb = max3f(mb, p1[r], p1[r + 1]); }
    float rm = max3f(ma, mb, p0[15]); rm = max2f(rm, p1[15]);
    { auto rr = __builtin_amdgcn_permlane32_swap(__float_as_uint(rm), __float_as_uint(rm), false, false); rm = max2f(__uint_as_float(rr[0]), __uint_as_float(rr[1])); }
    if (first || __any(rm > (float)THRL)) {
        const float dl = first ? rm : __builtin_fmaxf(rm, 0.f); mrun += dl;
        const float f = first ? 1.0f : __builtin_amdgcn_exp2f(-dl); ol[0] *= f;
#pragma unroll
        for (int r = 0; r < 16; ++r) { p0[r] -= dl; p1[r] -= dl; negm[r] = -mrun; }
#pragma unroll
        for (int d = 0; d < 4; ++d)
#pragma unroll
            for (int r = 0; r < 16; ++r) o[d][r] *= f;
    }
}
template <bool NOEXP = false>
__device__ __forceinline__ void softmax_exp(f32x16& p0, f32x16& p1, v8i32& pf) {
#pragma unroll
    for (int g = 0; g < 4; ++g) {
        const float e0 = __builtin_amdgcn_exp2f(p0[4 * g]), e1 = __builtin_amdgcn_exp2f(p0[4 * g + 1]); int w = __builtin_amdgcn_cvt_pk_fp8_f32(e0, e1, 0, false); DAT_SB();
        const float e2 = __builtin_amdgcn_exp2f(p0[4 * g + 2]), e3 = __builtin_amdgcn_exp2f(p0[4 * g + 3]); pf[g] = __builtin_amdgcn_cvt_pk_fp8_f32(e2, e3, w, true); DAT_SB();
    }
#pragma unroll
    for (int g = 0; g < 4; ++g) {
        const float e0 = __builtin_amdgcn_exp2f(p1[4 * g]), e1 = __builtin_amdgcn_exp2f(p1[4 * g + 1]); int w = __builtin_amdgcn_cvt_pk_fp8_f32(e0, e1, 0, false); DAT_SB();
        const float e2 = __builtin_amdgcn_exp2f(p1[4 * g + 2]), e3 = __builtin_amdgcn_exp2f(p1[4 * g + 3]); pf[4 + g] = __builtin_amdgcn_cvt_pk_fp8_f32(e2, e3, w, true); DAT_SB();
    }
}

struct Ctx { const unsigned char* tsrc; unsigned kdst, vdst; int wid, NT, tl, q0w, r32, hi; LAS const char* kp0; LAS const char* vp0; LAS const float* tab; };
#define DAT_DMA_K(C, t) glds16((C).tsrc + (size_t)(t) * KT_BLOCK, (unsigned)__builtin_amdgcn_readfirstlane((C).kdst + ((t) & 7) * KSLOT))
#define DAT_DMA_V(C, t) glds16((C).tsrc + (size_t)(t) * KT_BLOCK + 8192, (unsigned)__builtin_amdgcn_readfirstlane((C).vdst + ((t) & 7) * VSLOT))
#define DAT_WINDOW(C, t) do { if (MODE != 2) DAT_WAIT_BAR(0); if (MODE != 1 && MODE != 2 && (t) + 2 < (C).NT) { DAT_DMA_V(C, (t) + 2); DAT_DMA_K(C, (t) + 3); DAT_DMA_V(C, (t) + 3); if ((t) + 4 < (C).NT) DAT_DMA_K(C, (t) + 4); } } while (0)

#define DAT_VBLK(c0, c1, tau) do { \
        const int tau_ = (tau); \
        if (tau_ + 1 <= C.tl && MODE != 5) kread(kf, C.kp0 + ((tau_ + 1) & 7) * KSLOT); \
        DAT_SB(); \
        if (tau_ <= C.tl) { const bool near = 64 * tau_ > C.q0w - 191; const int ib = 64 * tau_ - C.q0w + 191 - C.r32 + 4 * C.hi; \
            int fv = (tau_ == 0); asm volatile("" : "+v"(fv)); const int fl = __builtin_amdgcn_readfirstlane(fv); \
            softmax_max<THRL>(fl != 0, c0, c1, negm, mrun, ol, o, near, ib, C.tab); DAT_SB(); \
            if (MODE != 5) vread(vA, C.vp0 + (tau_ & 7) * VSLOT, 0); DAT_SB(); \
            softmax_exp<MODE == 3>(c0, c1, pf); } \
        DAT_SB(); \
    } while (0)
#define DAT_MBLK(c0, c1, tau) do { \
        const int tau_ = (tau); \
        if (tau_ + 1 <= C.tl) qkmma<COMP>(c0, c1, kf, qf, ql, negm); \
        DAT_SB(); \
        if (tau_ <= C.tl) { LAS const char* vp = C.vp0 + (tau_ & 7) * VSLOT; VFrag vB = {}; \
            ol = __builtin_amdgcn_mfma_scale_f32_32x32x64_f8f6f4(ones, pf, ol, 0, 0, 0, 0, 0, 0); \
            DAT_SB(); if (MODE != 5) vread(vB, vp, 1); DAT_SB(); pvmma<MODE == 4>(o[0], vA, pf); DAT_SB(); \
            if (MODE != 5) vread(vA, vp, 2); DAT_SB(); pvmma<MODE == 4>(o[1], vB, pf); DAT_SB(); \
            if (MODE != 5) vread(vB, vp, 3); DAT_SB(); pvmma<MODE == 4>(o[2], vA, pf); DAT_SB(); \
            pvmma<MODE == 4>(o[3], vB, pf); DAT_SB(); } \
    } while (0)
template <int THRL, bool COMP, bool LAG, int MODE>
__device__ __forceinline__ void loop_p(const Ctx& C, const v8i32& qf, const v8i32& ql, f32x16 (&o)[4], float& lsum) {
    float mrun = 0.f; f32x16 negm = f32x16{}; v8i32 pf = v8i32{}; f32x16 ol = f32x16{};
    const int onew = C.r32 == 0 ? 0x38383838 : 0; const v8i32 ones = (v8i32){onew, onew, onew, onew, onew, onew, onew, onew};
    f32x16 a0, a1; VFrag kf[2] = {}, vA = {};
    DAT_WINDOW(C, 0);
    if (MODE != 5) kread(kf, C.kp0); DAT_SB(); qkmma<COMP>(a0, a1, kf, qf, ql, negm); DAT_SB();
    asm volatile("s_nop 15\n\ts_nop 7" : "+v"(a0), "+v"(a1));
    if constexpr (!LAG) {
        for (int t = 0;; t += 2) {
            DAT_VBLK(a0, a1, t); DAT_MBLK(a0, a1, t); DAT_VBLK(a0, a1, t + 1); DAT_MBLK(a0, a1, t + 1);
            if (t + 2 >= C.NT) break;
            DAT_WINDOW(C, t + 2);
        }
    } else {
        DAT_VBLK(a0, a1, 0); DAT_MBLK(a0, a1, 0); DAT_VBLK(a0, a1, 1);
        for (int t = 2; t < C.NT; t += 2) {
            DAT_WINDOW(C, t);
            DAT_MBLK(a0, a1, t - 1); DAT_VBLK(a0, a1, t); DAT_MBLK(a0, a1, t); DAT_VBLK(a0, a1, t + 1);
        }
        DAT_MBLK(a0, a1, C.NT - 1);
    }
    lsum = ol[0];
}
template <int THRL, int MODE = 0>
__device__ __forceinline__ void attn_unit(int b, int h, int xb, const bf16* __restrict__ Z, const unsigned char* __restrict__ KT, bf16* __restrict__ A2, const float* __restrict__ rel_bias, const float* __restrict__ subln, float lam, LAS char* shm) {
    int tid = threadIdx.x; asm volatile("" : "+v"(tid));
    const int lane = tid & 63, r32 = lane & 31, hi = lane >> 5; const int wid = __builtin_amdgcn_readfirstlane(tid >> 6);
    const int mp = wid >> 2, rw = wid & 3;
    const long rowbase = (long)b * SEQ; const int q0 = xb * 128, q0w = q0 + 32 * rw;
    const unsigned lds0 = (unsigned)(uintptr_t)shm;
    LAS float* tab = (LAS float*)(shm + L_TAB);
    { int tv = tid; asm volatile("" : "+v"(tv));
      if (tv < 255) { const int rel = tv - 191; tab[tv] = (rel_bias[rel_bucket(rel) * 4 + h] - rel_bias[15 * 4 + h]) * LOG2E; } }
    const bf16* Qw = Z + (rowbase + q0w + r32) * ZP + h * 128 + mp * 64 + hi * 32;
    v8i32 qf, ql;
#pragma unroll
    for (int ks = 0; ks < 4; ++ks) { const u32x4 qq = *(const u32x4*)(Qw + 8 * ks);
        const float q0 = bflo(qq.x), q1 = bfhi(qq.x), q2 = bflo(qq.y), q3 = bfhi(qq.y), q4 = bflo(qq.z), q5 = bfhi(qq.z), q6 = bflo(qq.w), q7 = bfhi(qq.w);
        const int a = (int)pk4_fp8(q0, q1, q2, q3), c = (int)pk4_fp8(q4, q5, q6, q7); qf[2 * ks] = a; qf[2 * ks + 1] = c;
        ql[2 * ks] = (int)pk4_fp8(q0 - __builtin_amdgcn_cvt_f32_fp8(a, 0), q1 - __builtin_amdgcn_cvt_f32_fp8(a, 1), q2 - __builtin_amdgcn_cvt_f32_fp8(a, 2), q3 - __builtin_amdgcn_cvt_f32_fp8(a, 3));
        ql[2 * ks + 1] = (int)pk4_fp8(q4 - __builtin_amdgcn_cvt_f32_fp8(c, 0), q5 - __builtin_amdgcn_cvt_f32_fp8(c, 1), q6 - __builtin_amdgcn_cvt_f32_fp8(c, 2), q7 - __builtin_amdgcn_cvt_f32_fp8(c, 3)); }
    asm volatile("" : "+v"(qf), "+v"(ql));
    Ctx C;
    C.tsrc = KT + (size_t)((b * 4 + h) * 128) * KT_BLOCK + wid * 1024 + lane * 16;
    C.kdst = lds0 + wid * 1024; C.vdst = lds0 + L_V + wid * 1024; C.wid = wid;
    C.NT = 2 * (xb + 1);
    C.tl = q0w >> 6;
    C.q0w = q0w; C.r32 = r32; C.hi = hi; C.tab = tab;
    C.kp0 = (LAS const char*)shm + mp * 4096 + hi * 2048 + r32 * 16;
    C.vp0 = (LAS const char*)shm + L_V + hi * 1024 + r32 * 32;
    if (MODE != 1 && MODE != 2) { DAT_DMA_K(C, 0); DAT_DMA_K(C, 1); DAT_DMA_V(C, 0); DAT_DMA_V(C, 1); if (C.NT > 2) DAT_DMA_K(C, 2); }
    float lsum = 0.f;
    f32x16 o[4]; o[0] = f32x16{}; o[1] = f32x16{}; o[2] = f32x16{}; o[3] = f32x16{};
    if (mp == 0) loop_p<THRL, true, false, MODE>(C, qf, ql, o, lsum); else loop_p<THRL, false, true, MODE>(C, qf, ql, o, lsum);
    { auto rr = __builtin_amdgcn_permlane32_swap(__float_as_uint(lsum), __float_as_uint(lsum), false, false); lsum = __uint_as_float(rr[0]) + __uint_as_float(rr[1]); }
    const float inv = 1.0f / lsum;
    DAT_WAIT_BAR(0);
    LAS float* ex = (LAS float*)shm + rw * 4096 + lane;
    if (mp == 1) {
        const float sc = inv * lam;
#pragma unroll
        for (int d = 0; d < 4; ++d)
#pragma unroll
            for (int r = 0; r < 16; ++r) ex[(d * 16 + r) * 64] = o[d][r] * sc;
    }
    DAT_WAIT_BAR(0);
    if (mp == 0) {
        float ss = 0.f;
#pragma unroll
        for (int d = 0; d < 4; ++d)
#pragma unroll
            for (int r = 0; r < 16; ++r) { const float a = o[d][r] * inv - ex[(d * 16 + r) * 64]; o[d][r] = a; ss += a * a; }
        { auto rr = __builtin_amdgcn_permlane32_swap(__float_as_uint(ss), __float_as_uint(ss), false, false); ss = __uint_as_float(rr[0]) + __uint_as_float(rr[1]); }
        const float rs = 0.8f / __builtin_sqrtf(ss * (1.0f / 128.0f) + 1e-6f);
        bf16* orow = A2 + (rowbase + q0w + r32) * 1024 + h * 128 + 4 * hi;
#pragma unroll
        for (int d = 0; d < 4; ++d)
#pragma unroll
            for (int g = 0; g < 4; ++g) {
                const f32x4 gn = *(const f32x4*)(subln + 32 * d + 8 * g + 4 * hi);
                u32x2 w; w.x = cvtpk(o[d][4 * g] * rs * gn[0], o[d][4 * g + 1] * rs * gn[1]); w.y = cvtpk(o[d][4 * g + 2] * rs * gn[2], o[d][4 * g + 3] * rs * gn[3]);
                st8(orow + 32 * d + 8 * g, w);
            }
    }
    DAT_WAIT_BAR(0);
}
}
constexpr int NWAVES = 8;
constexpr int BATCH = 2, SEQ = 8192, D = 1024, M = BATCH * SEQ, MEM = 256, NEXP = 16, FF = 256;
constexpr float EPS = 1e-6f, LOG2E = 1.4426950408889634f;
constexpr float C2 = 0.125f * LOG2E;
constexpr float CX = 0.0625f * LOG2E;
#ifndef MK_N_LAUNCHES
#define MK_N_LAUNCHES 1
#endif
constexpr int N_PHASES = 10;

constexpr size_t MiB = 1u << 20;
constexpr size_t WS_CTL = 0, CTL_ZERO_BYTES = 65536;
constexpr size_t WS_SSQ1 = 1 * MiB, WS_SSQ2 = 2 * MiB, WS_LIST = 3 * MiB, WS_LISTR = 4 * MiB, WS_LISTW = 5 * MiB, WS_WR = 6 * MiB  , WS_MN = 7 * MiB, WS_KVC = 8 * MiB;
constexpr size_t WS_WINT = 10 * MiB, WS_WOUTT = 14 * MiB, WS_WQN = 16 * MiB, WS_WKVT = 18 * MiB, WS_WOT = 22 * MiB, WS_WGUT = 24 * MiB, WS_WDT = 40 * MiB, WS_BTS = 48 * MiB, WS_BTO = 52 * MiB;
constexpr size_t WS_RA = 56 * MiB;
constexpr size_t WS_RB = 88 * MiB;
constexpr size_t WS_H2B = WS_RB + 32 * MiB;
constexpr size_t WS_RC = 152 * MiB;
constexpr size_t WS_RD = 184 * MiB;
constexpr size_t WS_XB = 216 * MiB;
constexpr size_t WS_WGUT8 = 248 * MiB;
constexpr size_t WS_END = 256 * MiB;
constexpr size_t WS_WTMP = WS_BTS;
constexpr size_t WS_PWS = WS_BTO;
constexpr size_t WS_RSX = WS_SSQ2;
constexpr int CW_BAR = 4096, XCD_BAR_WORDS_C = 3456;
static_assert(CW_BAR + XCD_BAR_WORDS_C <= 8192 && (8192 + 16 * 64) * 4 <= 65536, "control words inside the memset region");
constexpr int CW_PAN = 9216;
static_assert((CW_PAN + 3 * 64 * 16) * 4 <= 65536, "panel counters inside the memset region");
constexpr int CW_PAIR = 12800;
static_assert((CW_PAIR + 128 * 16) * 4 <= 65536, "pair counters inside the memset region");
constexpr int CW_XCC = 12288;
constexpr int CW_CNT = 8192;

constexpr int RING_OFF = 0, RING_BYTES = 148480;
constexpr int LDSCTL_OFF = RING_BYTES, MISC_OFF = LDSCTL_OFF + 320;
constexpr int LTAB_OFF = LDSCTL_OFF + 1024;
constexpr int LDS_BYTES = 163840;
static_assert(dat::LDS_BYTES <= RING_BYTES, "attention scratch inside the ring region");

typedef GAS unsigned gu32;
#define RLX_AGENT __ATOMIC_RELAXED, __HIP_MEMORY_SCOPE_AGENT
#define LDS_WAIT() asm volatile("s_waitcnt lgkmcnt(0)" ::: "memory")
#define VM_WAIT() asm volatile("s_waitcnt vmcnt(0)" ::: "memory")

#define XB_TMO      128
#define XB_XCNT(j)  (256  + 64 * (j))
#define XB_XSUB(j)  (1280 + 64 * (j))
#define XB_XGEN(j)  (2304 + 64 * (j))
#define XB_TOP      3328
#define XB_TOPGEN   3392
#define XCD_BAR_WORDS 3456
#define XB_SPIN_CAP (1u << 18)

__device__ __forceinline__ unsigned xb_ld(unsigned* p)              { return __hip_atomic_load(p, __ATOMIC_RELAXED, __HIP_MEMORY_SCOPE_AGENT); }
__device__ __forceinline__ unsigned xb_add(unsigned* p, unsigned v) { return __hip_atomic_fetch_add(p, v, __ATOMIC_RELAXED, __HIP_MEMORY_SCOPE_AGENT); }
__device__ __forceinline__ unsigned xb_xcc_id() { return (unsigned)__builtin_amdgcn_s_getreg((3 << 11) | 20) & 0xFu; }
#define XB_SPIN(cond, bar) do { unsigned _sp = 0; while (cond) { __builtin_amdgcn_s_sleep(1); \
    if ((++_sp & 255u) == 0u) { if (xb_ld(&(bar)[XB_TMO])) break; if (_sp > XB_SPIN_CAP) { atomicAdd(&(bar)[XB_TMO], 1u); break; } } } } while (0)

struct XcdBarrier {
    unsigned* bar; unsigned x;
    volatile LAS unsigned* st;
};
__device__ __forceinline__ XcdBarrier xcd_barrier_post(unsigned* bar, volatile LAS unsigned* st) {
    XcdBarrier b; b.bar = bar; b.x = xb_xcc_id(); b.st = st;
    if (threadIdx.x == 0) (void)xb_add(&bar[XB_XCNT(b.x)], 1u);
    return b;
}
__device__ __forceinline__ void xcd_barrier_complete(unsigned* bar, unsigned x, unsigned& nloc, unsigned& nx) {
    const unsigned G = gridDim.x * gridDim.y * gridDim.z;
    unsigned sum, cnt, mine, sp = 0u;
    for (;;) {
        sum = 0u; cnt = 0u; mine = 0u;
#pragma unroll
        for (unsigned j = 0; j < 16; ++j) { const unsigned c = xb_ld(&bar[XB_XCNT(j)]); sum += c; cnt += (c > 0u) ? 1u : 0u; mine = (j == x) ? c : mine; }
        if (sum == G) break;
        __builtin_amdgcn_s_sleep(1);
        if ((++sp & 255u) == 0u) { if (xb_ld(&bar[XB_TMO])) break; if (sp > XB_SPIN_CAP) { atomicAdd(&bar[XB_TMO], 1u); break; } }
    }
    nloc = mine > 0u ? mine : 1u; nx = cnt > 0u ? cnt : 1u;
}
__device__ __forceinline__ unsigned xcd_barrier_arrive(const XcdBarrier& b, bool rel = true) {
    asm volatile("s_waitcnt vmcnt(0)" ::: "memory");
    __syncthreads();
    unsigned gen = 0u;
    if (threadIdx.x == 0) {
        unsigned* bar = b.bar;
        __builtin_amdgcn_s_waitcnt(0);
        unsigned nloc = b.st[0], nx = b.st[1];
        if (nloc == 0u) { xcd_barrier_complete(bar, b.x, nloc, nx); b.st[0] = nloc; b.st[1] = nx; }
        const unsigned old = xb_add(&bar[XB_XSUB(b.x)], 1u);
        gen = old / nloc;
        if (old + 1u == (gen + 1u) * nloc) {
            if (rel) { __builtin_amdgcn_fence(__ATOMIC_RELEASE, "agent");
            asm volatile("s_waitcnt vmcnt(0)" ::: "memory"); }
#pragma unroll
            for (unsigned j = 0; j < 16; ++j) xb_add(&bar[XB_XGEN(j)], 1u);
        }
    }
    return gen;
}
__device__ __forceinline__ void xcd_barrier_wait(const XcdBarrier& b, unsigned gen) {
    if (threadIdx.x == 0) {
        const unsigned need = (gen + 1u) * b.st[1];
        XB_SPIN(xb_ld(&b.bar[XB_XGEN(b.x)]) < need, b.bar);
        __builtin_amdgcn_fence(__ATOMIC_ACQUIRE, "agent");
        asm volatile("s_waitcnt vmcnt(0)" ::: "memory");
    }
    __syncthreads();
}
__device__ __forceinline__ void xcd_barrier(const XcdBarrier& b) { const unsigned gen = xcd_barrier_arrive(b); xcd_barrier_wait(b, gen); }

__device__ __forceinline__ void panel_signal(unsigned* cnt, bool local) {
    asm volatile("s_waitcnt vmcnt(0)" ::: "memory");
    __syncthreads();
    if (threadIdx.x == 0) { if (!local) { __builtin_amdgcn_fence(__ATOMIC_RELEASE, "agent"); asm volatile("s_waitcnt vmcnt(0)" ::: "memory"); } (void)xb_add(cnt, 1u); }
}
__device__ __forceinline__ void panel_wait(unsigned* cnt, unsigned need, unsigned* tmo, bool acq = true) {
    if (threadIdx.x == 0) { XB_SPIN(xb_ld(cnt) < need, tmo - XB_TMO); if (acq) { __builtin_amdgcn_fence(__ATOMIC_ACQUIRE, "agent"); asm volatile("s_waitcnt vmcnt(0)" ::: "memory"); } }
    __syncthreads();
}

struct Frame {
    LAS unsigned char* lds;
    volatile LAS unsigned* MISC;
    gu32* ctl;
    int tid, lane, wave;
    int vcu, G;
    const float* in[27]; float* out; unsigned char* ws;
};
enum { I_X = 0, I_MEM, I_RELB, I_ANORM, I_WIN, I_LQ1, I_LK1, I_LQ2, I_LK2, I_SUBLN, I_POOLW, I_POOLS, I_WOUT, I_CNORM, I_MNORM, I_WQ, I_WKV, I_WO, I_FNORM, I_RG, I_RGB, I_RE, I_REB, I_WG, I_WU, I_WD, I_FINAL };

__device__ __forceinline__ float wave_sum(float v) {
#pragma unroll
    for (int o = 1; o < 64; o <<= 1) v += __shfl_xor(v, o);
    return v;
}

__device__ __forceinline__ void p0_transpose_load(float (&v)[32], const float* W, int ldw, int k0, int n0, int lane) {
    const float* src = W + (size_t)(k0 + (lane >> 5)) * ldw + n0 + (lane & 31);
#pragma unroll
    for (int i = 0; i < 32; ++i) v[i] = __builtin_nontemporal_load(src + (size_t)(2 * i) * ldw);
}
__device__ __forceinline__ void p0_transpose_store(float (&v)[32], int k0, bf16* WT, int ldt, int drow0, int dcol0, const float* gain, LAS float* scr, int lane, unsigned char* WT8 = nullptr, float s8 = 1.f) {
    if (gain) {
#pragma unroll
        for (int i = 0; i < 32; ++i) v[i] *= gain[k0 + 2 * i + (lane >> 5)]; }
#pragma unroll
    for (int i = 0; i < 32; ++i) scr[(2 * i + (lane >> 5)) * 33 + (lane & 31)] = v[i];
    LDS_WAIT(); asm volatile("" ::: "memory");
    const int c = lane & 7;
#pragma unroll
    for (int j = 0; j < 4; ++j) { const int n = (lane >> 3) + 8 * j; const LAS float* s = scr + (8 * c) * 33 + n;
        u32x4 o; o.x = cvtpk(s[0 * 33], s[1 * 33]); o.y = cvtpk(s[2 * 33], s[3 * 33]); o.z = cvtpk(s[4 * 33], s[5 * 33]); o.w = cvtpk(s[6 * 33], s[7 * 33]);
        if (WT) *(GAS u32x4*)(WT + (size_t)(drow0 + n) * ldt + dcol0 + 8 * c) = o;
        if (WT8) { u32x2 o8; o8.x = pk4_fp8(s[0 * 33] * s8, s[1 * 33] * s8, s[2 * 33] * s8, s[3 * 33] * s8); o8.y = pk4_fp8(s[4 * 33] * s8, s[5 * 33] * s8, s[6 * 33] * s8, s[7 * 33] * s8);
            *(GAS u32x2*)(WT8 + (size_t)(drow0 + n) * ldt + dcol0 + 8 * c) = o8; } }
    LDS_WAIT(); asm volatile("" ::: "memory");
}
__device__ __forceinline__ void p0_transpose_item(const float* W, int ldw, int k0, int n0, bf16* WT, int ldt, int drow0, int dcol0, const float* gain, LAS float* scr, int lane) {
    float v[32]; p0_transpose_load(v, W, ldw, k0, n0, lane); p0_transpose_store(v, k0, WT, ldt, drow0, dcol0, gain, scr, lane);
}
template <int NR>
__device__ __forceinline__ void rms_rows_to_bf16(const float* xrow, const float* g, bf16* orow, int lane) {
    const GAS f32x4* gr = (const GAS f32x4*)g + lane;
    f32x4 v[NR][4]; float s[NR];
#pragma unroll
    for (int r = 0; r < NR; ++r) { const GAS f32x4* xr = (const GAS f32x4*)(xrow + (size_t)r * D) + lane;
#pragma unroll
        for (int j = 0; j < 4; ++j) v[r][j] = __builtin_nontemporal_load(xr + 64 * j); }
#pragma unroll
    for (int r = 0; r < NR; ++r) { s[r] = 0.f;
#pragma unroll
        for (int j = 0; j < 4; ++j) s[r] += (v[r][j].x * v[r][j].x + v[r][j].y * v[r][j].y) + (v[r][j].z * v[r][j].z + v[r][j].w * v[r][j].w); }
#pragma unroll
    for (int r = 0; r < NR; ++r) { const float rstd = 1.f / __builtin_sqrtf(wave_sum(s[r]) * (1.f / D) + EPS);
        GAS u32x2* o8 = (GAS u32x2*)(orow + (size_t)r * D) + lane;
#pragma unroll
        for (int j = 0; j < 4; ++j) { const f32x4 gg = gr[64 * j]; u32x2 w; w.x = cvtpk(v[r][j].x * rstd * gg.x, v[r][j].y * rstd * gg.y); w.y = cvtpk(v[r][j].z * rstd * gg.z, v[r][j].w * rstd * gg.w); o8[64 * j] = w; } }
}

template <int NR>
__device__ __forceinline__ void rows_to_bf16_rstd(const float* xrow, bf16* orow, float* rstd_out, int lane) {
    f32x4 v[NR][4]; float s[NR];
#pragma unroll
    for (int r = 0; r < NR; ++r) { const GAS f32x4* xr = (const GAS f32x4*)(xrow + (size_t)r * D) + lane;
#pragma unroll
        for (int j = 0; j < 4; ++j) v[r][j] = __builtin_nontemporal_load(xr + 64 * j); }
#pragma unroll
    for (int r = 0; r < NR; ++r) { s[r] = 0.f; GAS u32x2* o8 = (GAS u32x2*)(orow + (size_t)r * D) + lane;
#pragma unroll
        for (int j = 0; j < 4; ++j) { s[r] += (v[r][j].x * v[r][j].x + v[r][j].y * v[r][j].y) + (v[r][j].z * v[r][j].z + v[r][j].w * v[r][j].w);
            u32x2 w; w.x = cvtpk(v[r][j].x, v[r][j].y); w.y = cvtpk(v[r][j].z, v[r][j].w); o8[64 * j] = w; } }
#pragma unroll
    for (int r = 0; r < NR; ++r) { const float t = wave_sum(s[r]); if (lane == 0) rstd_out[r] = 1.f / __builtin_sqrtf(t * (1.f / D) + EPS); }
}

template <int KS = 8, class Store>
__device__ __forceinline__ void small_gemm64(const bf16* A, int lda, const bf16* B, int ldb, int K, int wave, int lane, const Store& st) {
    const int fr = lane & 15, fq = lane >> 4;
    const bf16* ap = A + (size_t)(16 * (wave & 3) + fr) * lda + 8 * fq;
    const bf16* bp0 = B + (size_t)(32 * (wave >> 2) + fr) * ldb + 8 * fq;
    const bf16* bp1 = bp0 + (size_t)16 * ldb;
    f32x4 acc0 = {0.f, 0.f, 0.f, 0.f}, acc1 = {0.f, 0.f, 0.f, 0.f};
    for (int k = 0; k < K; k += 32 * KS) {
        bf16x8 a[KS], b0[KS], b1[KS];
#pragma unroll
        for (int s = 0; s < KS; ++s) { a[s] = *(const GAS bf16x8*)(ap + k + 32 * s); b0[s] = *(const GAS bf16x8*)(bp0 + k + 32 * s); b1[s] = *(const GAS bf16x8*)(bp1 + k + 32 * s); }
#pragma unroll
        for (int s = 0; s < KS; ++s) { acc0 = __builtin_amdgcn_mfma_f32_16x16x32_bf16(b0[s], a[s], acc0, 0, 0, 0); acc1 = __builtin_amdgcn_mfma_f32_16x16x32_bf16(b1[s], a[s], acc1, 0, 0, 0); }
    }
    const int row = 16 * (wave & 3) + fr, col = 32 * (wave >> 2) + 4 * fq;
    st(row, col, acc0); st(row, col + 16, acc1);
}
struct TileJob { const bf16* A; const bf16* B; bf16* C; int lda, ldb, ldc; int c8; };
template <class Get> struct PlainJobs { Get get;
    __device__ __forceinline__ const bf16* arow(int j, int lane) const { const TileJob t = get(j); return t.A + (size_t)lane * t.lda; }
    __device__ __forceinline__ const bf16* brow(int j, int lane) const { const TileJob t = get(j); return t.B + (size_t)lane * t.ldb; }
    __device__ __forceinline__ void store(int j, int wave, int lane, f32x4 acc0, f32x4 acc1) const { const TileJob t = get(j);
        if (t.c8) { unsigned char* c8p = (unsigned char*)t.C + (size_t)(16 * (wave & 3) + (lane & 15)) * t.ldc + 32 * (wave >> 2) + 4 * (lane >> 4);
            *(GAS unsigned*)c8p = pk4_fp8(acc0[0], acc0[1], acc0[2], acc0[3]); *(GAS unsigned*)(c8p + 16) = pk4_fp8(acc1[0], acc1[1], acc1[2], acc1[3]); return; }
        bf16* cp = t.C + (size_t)(16 * (wave & 3) + (lane & 15)) * t.ldc + 32 * (wave >> 2) + 4 * (lane >> 4);
        u32x2 w; w.x = cvtpk(acc0[0], acc0[1]); w.y = cvtpk(acc0[2], acc0[3]); *(GAS u32x2*)cp = w; w.x = cvtpk(acc1[0], acc1[1]); w.y = cvtpk(acc1[2], acc1[3]); *(GAS u32x2*)(cp + 16) = w; }
};
template <int KCH, int NSTEP, bool F8 = false, class Jobs>
__device__ __forceinline__ void tile_pipe(LAS char* lds, int njobs, const Jobs& jobs, int wave, int lane) {
    constexpr int CPR = KCH / 8, RPP = 64 / CPR, ROWB = CPR * 16, OPB = 64 * ROWB, BUFB = 2 * OPB, PPO = 64 / RPP / 8, NB = (128 * 1024 / BUFB) >= 4 ? 4 : 2, DEPTH = NB - 1, OPS = 2 * PPO;
    const unsigned lds0 = (unsigned)(uintptr_t)lds; const int fr = lane & 15, fq = lane >> 4;
    const int nsteps = njobs * NSTEP;
    if (nsteps <= 0) return;
    const int rip = lane / CPR, slot = lane % CPR;
    const bf16* ar_[PPO]; const bf16* br_[PPO];
#define TP_DMA(st, buf) do { const int k0_ = ((st) % NSTEP) * KCH; \
        if (k0_ == 0) { _Pragma("unroll") for (int i_ = 0; i_ < PPO; ++i_) { const int row_ = (wave * PPO + i_) * RPP + rip; const int ch_ = (slot & 16) | ((slot ^ row_) & 15); \
            ar_[i_] = jobs.arow((st) / NSTEP, row_) + 8 * ch_; br_[i_] = jobs.brow((st) / NSTEP, row_) + 8 * ch_; } } \
        _Pragma("unroll") for (int i_ = 0; i_ < PPO; ++i_) { \
            dat::glds16(ar_[i_] + k0_, (unsigned)__builtin_amdgcn_readfirstlane(lds0 + (buf) * BUFB + (wave * PPO + i_) * 1024)); \
            dat::glds16(br_[i_] + k0_, (unsigned)__builtin_amdgcn_readfirstlane(lds0 + (buf) * BUFB + OPB + (wave * PPO + i_) * 1024)); } } while (0)
#pragma unroll
    for (int s_ = 0; s_ < DEPTH; ++s_) if (s_ < nsteps) TP_DMA(s_, s_);
    f32x4 acc0 = {0.f, 0.f, 0.f, 0.f}, acc1 = {0.f, 0.f, 0.f, 0.f};
    const int x0 = fq ^ fr;
    const int aoff = (16 * (wave & 3) + fr) * ROWB, boff = OPB + (32 * (wave >> 2) + fr) * ROWB;
    for (int st = 0; st < nsteps; ++st) {
        { const int yg = nsteps - 1 - st;
          if (DEPTH >= 3 && yg >= 2) asm volatile("s_waitcnt vmcnt(%0) lgkmcnt(0)\n\ts_barrier" :: "n"(2 * OPS) : "memory");
          else if (DEPTH >= 3 && yg == 1) asm volatile("s_waitcnt vmcnt(%0) lgkmcnt(0)\n\ts_barrier" :: "n"(OPS) : "memory");
          else asm volatile("s_waitcnt vmcnt(0) lgkmcnt(0)\n\ts_barrier" ::: "memory"); }
        if (st + DEPTH < nsteps) TP_DMA(st + DEPTH, (st + DEPTH) % NB);
        LAS const char* bp = lds + (st % NB) * BUFB;
        if constexpr (F8) {
#pragma unroll
            for (int s3 = 0; s3 < KCH / 64; ++s3) {
                const int so0 = ((((8 * s3) ^ x0) & 15) | ((8 * s3) & 16)) * 16, so1 = ((((8 * s3 + 4) ^ x0) & 15) | ((8 * s3 + 4) & 16)) * 16;
                const v4i32 al = *(LAS const v4i32*)(bp + aoff + so0), ah = *(LAS const v4i32*)(bp + aoff + so1), b0l = *(LAS const v4i32*)(bp + boff + so0), b0h = *(LAS const v4i32*)(bp + boff + so1),
                            b1l = *(LAS const v4i32*)(bp + boff + 16 * ROWB + so0), b1h = *(LAS const v4i32*)(bp + boff + 16 * ROWB + so1);
                const v8i32 a8 = __builtin_shufflevector(al, ah, 0, 1, 2, 3, 4, 5, 6, 7), b08 = __builtin_shufflevector(b0l, b0h, 0, 1, 2, 3, 4, 5, 6, 7), b18 = __builtin_shufflevector(b1l, b1h, 0, 1, 2, 3, 4, 5, 6, 7);
                acc0 = __builtin_amdgcn_mfma_scale_f32_16x16x128_f8f6f4(b08, a8, acc0, 0, 0, 0, 0, 0, 0); acc1 = __builtin_amdgcn_mfma_scale_f32_16x16x128_f8f6f4(b18, a8, acc1, 0, 0, 0, 0, 0, 0);
            }
        } else {
#pragma unroll
        for (int s2 = 0; s2 < KCH / 32; ++s2) {
            const int so = ((((4 * s2) ^ x0) & 15) | ((4 * s2) & 16)) * 16;
            const bf16x8 a = *(LAS const bf16x8*)(bp + aoff + so), b0 = *(LAS const bf16x8*)(bp + boff + so), b1 = *(LAS const bf16x8*)(bp + boff + 16 * ROWB + so);
            acc0 = __builtin_amdgcn_mfma_f32_16x16x32_bf16(b0, a, acc0, 0, 0, 0); acc1 = __builtin_amdgcn_mfma_f32_16x16x32_bf16(b1, a, acc1, 0, 0, 0);
        }
        }
        if ((st % NSTEP) == NSTEP - 1) { jobs.store(st / NSTEP, wave, lane, acc0, acc1); acc0 = (f32x4){0.f, 0.f, 0.f, 0.f}; acc1 = (f32x4){0.f, 0.f, 0.f, 0.f}; }
    }
    asm volatile("s_waitcnt vmcnt(0) lgkmcnt(0)\n\ts_barrier" ::: "memory");
#undef TP_DMA
}
struct StoreBf16 { bf16* C; int ldc;
    __device__ __forceinline__ void operator()(int row, int col, f32x4 v) const { u32x2 w; w.x = cvtpk(v[0], v[1]); w.y = cvtpk(v[2], v[3]); *(GAS u32x2*)(C + (size_t)row * ldc + col) = w; } };
namespace pg8 {
struct EpiBf16 { static constexpr bool PERM = true, AFTER_DRAIN = false; bf16* O; int ldc; int scale_cols; float scale0;
    __device__ __forceinline__ void operator()(const f32x4 (&acc)[2][2][4][2], const Unit& u, int wr, int wc, int fr, int fq) const {
        const int row0 = u.pm * BM + wr * 64 + fr, colt = u.pn * BM; const float sc = colt < scale_cols ? scale0 : 1.f; const int col0 = colt + wc * 32 + 8 * fq;
#pragma unroll
        for (int ai = 0; ai < 2; ++ai)
#pragma unroll
            for (int m = 0; m < 4; ++m) { bf16* rowp = O + (size_t)(row0 + ai * HALF + m * 16) * ldc + col0;
#pragma unroll
                for (int bj = 0; bj < 2; ++bj) { const f32x4 v0 = acc[ai][bj][m][0] * sc, v1 = acc[ai][bj][m][1] * sc;
                    u32x4 w; w.x = cvtpk(v0[0], v0[1]); w.y = cvtpk(v0[2], v0[3]); w.z = cvtpk(v1[0], v1[1]); w.w = cvtpk(v1[2], v1[3]); st16(rowp + bj * HALF, w); } }
    }
};
struct EpiZ { static constexpr bool PERM = true, AFTER_DRAIN = false; bf16* Z; unsigned char* KT; float qscale; const float* rsx; LAS unsigned char* vscr;
    __device__ __forceinline__ void operator()(const f32x4 (&acc)[2][2][4][2], const Unit& u, int wr, int wc, int fr, int fq) const {
        const int kind = u.pn >> 1;
        float rs[2][4];
#pragma unroll
        for (int ai = 0; ai < 2; ++ai)
#pragma unroll
            for (int m = 0; m < 4; ++m) rs[ai][m] = rsx[u.pm * BM + ai * HALF + wr * 64 + m * 16 + fr];
        if (kind == 0 || kind == 3) {
            const int row0 = u.pm * BM + wr * 64 + fr, col0 = u.pn * BM + wc * 32 + 8 * fq; const float sc = kind == 0 ? qscale : 1.f;
#pragma unroll
            for (int ai = 0; ai < 2; ++ai)
#pragma unroll
                for (int m = 0; m < 4; ++m) { bf16* rowp = Z + (size_t)(row0 + ai * HALF + m * 16) * 2048 + col0; const float sr = sc * rs[ai][m];
#pragma unroll
                    for (int bj = 0; bj < 2; ++bj) { const f32x4 v0 = acc[ai][bj][m][0] * sr, v1 = acc[ai][bj][m][1] * sr;
                        u32x4 w; w.x = cvtpk(v0[0], v0[1]); w.y = cvtpk(v0[2], v0[3]); w.z = cvtpk(v1[0], v1[1]); w.w = cvtpk(v1[2], v1[3]); st16(rowp + bj * HALF, w); } }
        } else if (kind == 1) {
            const int b = u.pm >> 5, t0 = (u.pm & 31) * 4 + wr;
            const unsigned inb = (unsigned)((wc >> 1) * 4096 + ((wc & 1) * 2 + (fq >> 1)) * 1024 + fr * 16 + 8 * (fq & 1));
#pragma unroll
            for (int bj = 0; bj < 2; ++bj) { const int h = (u.pn & 1) * 2 + bj;
#pragma unroll
                for (int ai = 0; ai < 2; ++ai) { unsigned char* blk = KT + (size_t)(((b * 4 + h) * 128) + t0 + 2 * ai) * 16384 + inb;
#pragma unroll
                    for (int m = 0; m < 4; ++m) { const f32x4 v0 = acc[ai][bj][m][0] * rs[ai][m], v1 = acc[ai][bj][m][1] * rs[ai][m];
                        u32x2 w; w.x = pk4_fp8(v0[0], v0[1], v0[2], v0[3]); w.y = pk4_fp8(v1[0], v1[1], v1[2], v1[3]); st8(blk + m * 256, w); } } }
        } else {
            const int b = u.pm >> 5, t0 = (u.pm & 31) * 4 + wr; const int wave = wr * 4 + wc;
            LAS unsigned char* sc = vscr + wave * 2048; const int hik = (fr >> 2) & 1, r0 = (fr & 3) + 4 * (fr >> 3);
#pragma unroll
            for (int bj = 0; bj < 2; ++bj) { const int h = (u.pn & 1) * 2 + bj;
#pragma unroll
                for (int ai = 0; ai < 2; ++ai) {
#pragma unroll
                    for (int m = 0; m < 4; ++m) { const int bb = 16 * (m >> 1) + r0 + 8 * (m & 1);
#pragma unroll
                        for (int n = 0; n < 2; ++n)
#pragma unroll
                            for (int i = 0; i < 4; ++i) { const float x = acc[ai][bj][m][n][i] * rs[ai][m]; const int w = __builtin_amdgcn_cvt_pk_fp8_f32(x, x, 0, false);
                                sc[hik * 1024 + (8 * fq + 4 * n + i) * 32 + bb] = (unsigned char)w; } }
                    asm volatile("s_waitcnt lgkmcnt(0)" ::: "memory");
                    const int lane = fq * 16 + fr; const u32x4 o0 = *(const LAS u32x4*)(sc + lane * 32), o1 = *(const LAS u32x4*)(sc + lane * 32 + 16);
                    unsigned char* blk = KT + (size_t)(((b * 4 + h) * 128) + t0 + 2 * ai) * 16384 + 8192 + wc * 2048 + lane * 32;
                    st16(blk, o0); st16(blk + 16, o1);
                    asm volatile("s_waitcnt lgkmcnt(0)" ::: "memory"); } }
        }
    }
};
template <bool BASE_BF16, bool OUT8 = false> struct EpiRes { static constexpr bool PERM = true, AFTER_DRAIN = false; const void* base; bf16* outb; float* ssq; unsigned char* out8; float ascale;
    __device__ __forceinline__ void operator()(const f32x4 (&acc)[2][2][4][2], const Unit& u, int wr, int wc, int fr, int fq) const {
        const int row0 = u.pm * BM + wr * 64 + fr, col0 = u.pn * BM + wc * 32 + 8 * fq;
#pragma unroll
        for (int ai = 0; ai < 2; ++ai)
#pragma unroll
            for (int m = 0; m < 4; ++m) { const int row = row0 + ai * HALF + m * 16; const size_t off = (size_t)row * 1024 + col0; float ss = 0.f;
#pragma unroll
                for (int bj = 0; bj < 2; ++bj) { f32x4 b0, b1;
                    if (BASE_BF16) { const u32x4 bw = *(const u32x4*)((const bf16*)base + off + bj * HALF); b0 = (f32x4){bflo(bw.x), bfhi(bw.x), bflo(bw.y), bfhi(bw.y)}; b1 = (f32x4){bflo(bw.z), bfhi(bw.z), bflo(bw.w), bfhi(bw.w)}; }
                    else { b0 = *(const f32x4*)((const float*)base + off + bj * HALF); b1 = *(const f32x4*)((const float*)base + off + bj * HALF + 4); }
                    const f32x4 v0 = acc[ai][bj][m][0] * ascale + b0, v1 = acc[ai][bj][m][1] * ascale + b1;
                    u32x4 w; w.x = cvtpk(v0[0], v0[1]); w.y = cvtpk(v0[2], v0[3]); w.z = cvtpk(v1[0], v1[1]); w.w = cvtpk(v1[2], v1[3]); st16(outb + off + bj * HALF, w);
                    if constexpr (OUT8) { u32x2 w8; w8.x = pk4_fp8(v0[0], v0[1], v0[2], v0[3]); w8.y = pk4_fp8(v1[0], v1[1], v1[2], v1[3]); *(u32x2*)(out8 + off + bj * HALF) = w8; }
                    ss += (v0[0] * v0[0] + v0[1] * v0[1]) + (v0[2] * v0[2] + v0[3] * v0[3]) + (v1[0] * v1[0] + v1[1] * v1[1]) + (v1[2] * v1[2] + v1[3] * v1[3]); }
                ss += __shfl_xor(ss, 16); ss += __shfl_xor(ss, 32);
                if (fq == 0) ssq[(size_t)row * 16 + u.pn * 4 + wc] = ss;
                if (m == 3) asm volatile("" ::: "memory"); }
    }
};
struct EpiSoftmax { static constexpr bool PERM = true, AFTER_DRAIN = true; const float* ssq; unsigned char* P;
    __device__ __forceinline__ void operator()(const f32x4 (&)[2][2][4][2], const Unit&, int, int, int, int) const {}
    __device__ __forceinline__ void fused(f32x4 (&acc)[2][2][4][2], const Unit& u, int wr, int wc, int fr, int fq, LAS unsigned char* lds, int wid, int lane) const {
        LAS float* PM = (LAS float*)lds; LAS float* PS = PM + 1024;
#pragma unroll
        for (int ai = 0; ai < 2; ++ai)
#pragma unroll
            for (int m = 0; m < 4; ++m) { const int rt = ai * HALF + wr * 64 + m * 16 + fr; const f32x4* sp = (const f32x4*)(ssq + (size_t)(u.pm * BM + rt) * 16);
                const f32x4 s0 = sp[0], s1 = sp[1], s2 = sp[2], s3 = sp[3]; const f32x4 st = (s0 + s1) + (s2 + s3);
                const float rs = CX / __builtin_sqrtf(((st[0] + st[1]) + (st[2] + st[3])) * (1.0f / 1024.0f) + EPS);
                float mx = -3.0e38f;
#pragma unroll
                for (int bj = 0; bj < 2; ++bj)
#pragma unroll
                    for (int n = 0; n < 2; ++n) { f32x4 v = acc[ai][bj][m][n] * rs; acc[ai][bj][m][n] = v; mx = __builtin_fmaxf(mx, __builtin_fmaxf(__builtin_fmaxf(v[0], v[1]), __builtin_fmaxf(v[2], v[3]))); }
                mx = __builtin_fmaxf(mx, __shfl_xor(mx, 16)); mx = __builtin_fmaxf(mx, __shfl_xor(mx, 32));
                if (fq == 0) PM[rt * 4 + wc] = mx; }
        asm volatile("s_waitcnt lgkmcnt(0)" ::: "memory"); __builtin_amdgcn_s_barrier(); asm volatile("" ::: "memory");
#pragma unroll
        for (int ai = 0; ai < 2; ++ai)
#pragma unroll
            for (int m = 0; m < 4; ++m) { const int rt = ai * HALF + wr * 64 + m * 16 + fr; const f32x4 m4 = *(const LAS f32x4*)(PM + rt * 4);
                const float mx = __builtin_fmaxf(__builtin_fmaxf(m4[0], m4[1]), __builtin_fmaxf(m4[2], m4[3])); float sm = 0.f;
#pragma unroll
                for (int bj = 0; bj < 2; ++bj)
#pragma unroll
                    for (int n = 0; n < 2; ++n) { f32x4 v = acc[ai][bj][m][n]; v[0] = __builtin_amdgcn_exp2f(v[0] - mx); v[1] = __builtin_amdgcn_exp2f(v[1] - mx); v[2] = __builtin_amdgcn_exp2f(v[2] - mx); v[3] = __builtin_amdgcn_exp2f(v[3] - mx);
                        acc[ai][bj][m][n] = v; sm += (v[0] + v[1]) + (v[2] + v[3]); }
                sm += __shfl_xor(sm, 16); sm += __shfl_xor(sm, 32);
                if (fq == 0) PS[rt * 4 + wc] = sm; }
        asm volatile("s_waitcnt lgkmcnt(0)" ::: "memory"); __builtin_amdgcn_s_barrier(); asm volatile("" ::: "memory");
        const int col0 = u.pn * BM + wc * 32 + 8 * fq;
#pragma unroll
        for (int ai = 0; ai < 2; ++ai)
#pragma unroll
            for (int m = 0; m < 4; ++m) { const int rt = ai * HALF + wr * 64 + m * 16 + fr; const f32x4 s4 = *(const LAS f32x4*)(PS + rt * 4);
                const float inv = 256.0f / ((s4[0] + s4[1]) + (s4[2] + s4[3])); unsigned char* rowp = P + (size_t)(u.pm * BM + rt) * 1024 + col0;
#pragma unroll
                for (int bj = 0; bj < 2; ++bj) { const f32x4 v0 = acc[ai][bj][m][0] * inv, v1 = acc[ai][bj][m][1] * inv;
                    u32x2 w; w.x = pk4_fp8(v0[0], v0[1], v0[2], v0[3]); w.y = pk4_fp8(v1[0], v1[1], v1[2], v1[3]); *(u32x2*)(rowp + bj * HALF) = w; } }
    }
};
struct EpiGateUp { static constexpr bool PERM = true, AFTER_DRAIN = false; unsigned char* ACT; const float* listr; const float* listw; float ascale;
    __device__ __forceinline__ void operator()(const f32x4 (&acc)[2][2][4][2], const Unit& u, int wr, int wc, int fr, int fq) const {
#pragma unroll
        for (int ai = 0; ai < 2; ++ai)
#pragma unroll
            for (int m = 0; m < 4; ++m) { const int r = ai * HALF + wr * 64 + m * 16 + fr; const bool ok = r < u.nval;
                const float rs = ok ? listr[u.lofs + r] * ascale : 0.f, cw = ok ? listw[u.lofs + r] * 8.0f : 0.f; f32x4 a[2];
#pragma unroll
                for (int n = 0; n < 2; ++n)
#pragma unroll
                    for (int i = 0; i < 4; ++i) { const float g = acc[ai][0][m][n][i] * rs, up = acc[ai][1][m][n][i] * rs; a[n][i] = __builtin_amdgcn_fmed3f(g * __builtin_amdgcn_rcpf(1.0f + __builtin_amdgcn_exp2f(-g * LOG2E)) * up * cw, -448.0f, 448.0f); }
                u32x2 w; w.x = pk4_fp8(a[0][0], a[0][1], a[0][2], a[0][3]); w.y = pk4_fp8(a[1][0], a[1][1], a[1][2], a[1][3]);
                st8(ACT + (size_t)(u.row0 + r) * 256 + u.pn * HALF + wc * 32 + 8 * fq, w); }
    }
};
struct EpiDown { static constexpr bool PERM = true, AFTER_DRAIN = false; unsigned char* YS; const int* list; float ascale;
    __device__ __forceinline__ void operator()(const f32x4 (&acc)[2][2][4][2], const Unit& u, int wr, int wc, int fr, int fq) const {
        const unsigned colp = (unsigned)(u.pn * BM + wc * 32 + 8 * fq); const int* lp = list + u.lofs + wr * 64 + fr;
#pragma unroll
        for (int ai = 0; ai < 2; ++ai)
#pragma unroll
            for (int m = 0; m < 4; ++m) { const int r = ai * HALF + wr * 64 + m * 16 + fr;
                if (r < u.nval) { const unsigned v = (unsigned)lp[ai * HALF + m * 16]; const unsigned eo = ((((v & 1u) << 14) + (v >> 1)) << 10) + colp;
#pragma unroll
                    for (int bj = 0; bj < 2; ++bj) { const f32x4 v0 = acc[ai][bj][m][0] * ascale, v1 = acc[ai][bj][m][1] * ascale;
                        u32x2 w; w.x = pk4_fp8(__builtin_amdgcn_fmed3f(v0[0], -448.f, 448.f), __builtin_amdgcn_fmed3f(v0[1], -448.f, 448.f), __builtin_amdgcn_fmed3f(v0[2], -448.f, 448.f), __builtin_amdgcn_fmed3f(v0[3], -448.f, 448.f));
                        w.y = pk4_fp8(__builtin_amdgcn_fmed3f(v1[0], -448.f, 448.f), __builtin_amdgcn_fmed3f(v1[1], -448.f, 448.f), __builtin_amdgcn_fmed3f(v1[2], -448.f, 448.f), __builtin_amdgcn_fmed3f(v1[3], -448.f, 448.f)); st8(YS + eo + bj * HALF, w); } }
                asm volatile("" ::: "memory"); }
    }
};

template <int NCT, bool GATH> struct MoeOrder {
    static constexpr bool GATHER = GATH;
    LAS const int* tab; const char* A; const char* B; const int* list; int G, c, nunits; size_t bexp, btile; size_t apitch = FF * 2; bool pair = false;
    __device__ __forceinline__ bool next(int i, Unit& u) const {
        int L = i * G + c;
        if (pair) { if (i >= 2 || c >= (nunits >> 1)) return false; L = (c >> 1) * NCT + 2 * (c & 1) + i; }
        else if (L >= nunits) return false;
        const int rtg = L / NCT; int e = 0;
#pragma unroll
        for (int j = 1; j < 16; ++j) e += (rtg >= tab[64 + j]) ? 1 : 0;
        e = __builtin_amdgcn_readfirstlane(e);
        const int ptf = __builtin_amdgcn_readfirstlane(tab[64 + e]), pt = __builtin_amdgcn_readfirstlane(tab[e]); const int rt = rtg - ptf;
        u.pm = rt; u.pn = L % NCT; u.e = e; u.row0 = (pt + rt) * 256; u.nval = 256; u.lofs = e * 16384 + rt * 256; return true;
    }
    __device__ __forceinline__ const char* a_base(const Unit& u) const { return GATH ? A : A + (size_t)u.row0 * apitch; }
    __device__ __forceinline__ const char* b_base(const Unit& u) const { return B + (size_t)u.e * bexp + (size_t)u.pn * btile; }
    __device__ __forceinline__ void gather(const Unit& u, const int (&Rl)[2], const int (&Cl)[2], int K, unsigned (&vo)[2][2]) const {
#pragma unroll
        for (int h = 0; h < 2; ++h)
#pragma unroll
            for (int i = 0; i < 2; ++i) { const int r = Rl[i] + HALF * h; const int tok = list[u.lofs + r] >> 1; vo[h][i] = (unsigned)(tok * K + Cl[i]) * 2u; }
    }
};
}

template <int PARTS>
__device__ __forceinline__ void p0_prologue(Frame& F) {
    LAS float* scr = (LAS float*)(F.lds + RING_OFF + F.wave * 16384);
    const int gw = F.vcu * NWAVES + F.wave, NGW = F.G * NWAVES, lane = F.lane;
    unsigned char* ws = F.ws;
    const int gi = F.wave * F.G + F.vcu;
    constexpr int N_A = 1024, N_BP = 256, N_C = 1024, N_I = 128, N_BA = 256, N_D = 512, N_H = 2048, N_J = 512;
    if (PARTS & 1) {
    for (int m = F.wave * F.G + F.vcu; m < BATCH * MEM; m += NGW) rms_rows_to_bf16<1>(F.in[I_MEM] + (size_t)m * D, F.in[I_MNORM], (bf16*)(ws + WS_MN) + (size_t)m * D, lane);
    for (int m = 2 * gw; m < M; m += 2 * NGW) rows_to_bf16_rstd<2>(F.in[I_X] + (size_t)m * D, (bf16*)(ws + WS_XB) + (size_t)m * D, (float*)(ws + WS_RSX) + m, lane);
    for (int it = gi; it < N_A + N_BP + N_C + N_I; it += NGW) {
        int r = it;
        if (r < N_A) { p0_transpose_item(F.in[I_WIN], 2048, (r >> 6) * 64, (r & 63) * 32, (bf16*)(ws + WS_WINT), 1024, (r & 63) * 32, (r >> 6) * 64, F.in[I_ANORM], scr, lane); continue; } r -= N_A;
        if (r < N_BP) { const int k0 = 512 + (r >> 5) * 64, n0 = (r & 31) * 32;
            p0_transpose_item(F.in[I_WOUT], 1024, k0, n0, (bf16*)(ws + WS_WTMP), 512, n0, k0 - 512, nullptr, scr, lane); continue; } r -= N_BP;
        if (r < N_C) { p0_transpose_item(F.in[I_WKV], 2048, (r >> 6) * 64, (r & 63) * 32, (bf16*)(ws + WS_WKVT), 1024, (r & 63) * 32, (r >> 6) * 64, nullptr, scr, lane); continue; } r -= N_C;
        { const int e0 = r * 512 + lane * 8;
            const float* pw = F.in[I_POOLW] + e0; const float* ps = F.in[I_POOLS] + (e0 >> 14) * 128 + (e0 & 127);
            const f32x4 a = *(const f32x4*)pw * *(const f32x4*)ps, b = *(const f32x4*)(pw + 4) * *(const f32x4*)(ps + 4);
            u32x4 w; w.x = cvtpk(a[0], a[1]); w.y = cvtpk(a[2], a[3]); w.z = cvtpk(b[0], b[1]); w.w = cvtpk(b[2], b[3]);
            *(u32x4*)((bf16*)(ws + WS_PWS) + e0) = w; }
    } }
    if (PARTS & 2) {
    for (int it = gi; it < N_BA + N_D + N_H + N_J; it += NGW) {
        int r = it;
        if (r < N_BA) { const int k0 = (r >> 5) * 64, n0 = (r & 31) * 32;
            p0_transpose_item(F.in[I_WOUT], 1024, k0, n0, (bf16*)(ws + WS_WOUTT), 1024, n0, k0, nullptr, scr, lane); continue; } r -= N_BA;
        if (r < N_D) { p0_transpose_item(F.in[I_WO], 1024, (r >> 5) * 64, (r & 31) * 32, (bf16*)(ws + WS_WOT), 1024, (r & 31) * 32, (r >> 5) * 64, nullptr, scr, lane); continue; } r -= N_D;
        if (r < N_H) { const int k = r >> 1, c0 = (r & 1) * 512 + lane * 8; const float g = F.in[I_CNORM][k]; const float* src = F.in[I_WQ] + (size_t)k * 1024 + c0;
            const f32x4 a = __builtin_nontemporal_load((const f32x4*)src) * g, b = __builtin_nontemporal_load((const f32x4*)(src + 4)) * g; u32x4 w; w.x = cvtpk(a[0], a[1]); w.y = cvtpk(a[2], a[3]); w.z = cvtpk(b[0], b[1]); w.w = cvtpk(b[2], b[3]);
            *(u32x4*)((bf16*)(ws + WS_WQN) + (size_t)k * 1024 + c0) = w; continue; } r -= N_H;
        { const int idx = r * 64 + lane, j = idx >> 10, k = idx & 1023;
            float v = 0.f; if (j < 16) v = F.in[I_RE][((size_t)(j >> 2) * 1024 + k) * 4 + (j & 3)]; else if (j < 20) v = F.in[I_RG][(size_t)k * 4 + (j - 16)];
            v *= F.in[I_FNORM][k]; const unsigned hi = cvtpk(v, 0.f) & 0xffffu; const unsigned lo = cvtpk(v - bflo(hi), 0.f) & 0xffffu;
            ((bf16*)(ws + WS_WR))[idx] = (bf16)hi; ((bf16*)(ws + WS_WR + 65536))[idx] = (bf16)lo; }
    } }
}

template <int W>
__device__ __forceinline__ void pool_unit_w(int b, int g, int xb, const bf16* Z, bf16* A2, int tid) {
    const int cv = tid & 15, rg = tid >> 4, t0 = xb * 128 + 4 * rg;
    const bf16* up = Z + ((size_t)b * SEQ + t0) * 2048 + 1536 + g * 128 + 8 * cv; bf16* op = A2 + ((size_t)b * SEQ + t0) * 1024 + 512 + g * 128 + 8 * cv;
    u32x4 x[W + 3];
#pragma unroll
    for (int i = 0; i < W + 3; ++i) { const int dt = i - (W - 1); x[i] = (t0 + dt >= 0) ? *(const u32x4*)(up + (long)dt * 2048) : (u32x4){0u, 0u, 0u, 0u}; }
    float s[8];
#pragma unroll
    for (int c = 0; c < 8; ++c) s[c] = 0.f;
#pragma unroll
    for (int i = 0; i < W; ++i)
#pragma unroll
        for (int c = 0; c < 4; ++c) { s[2 * c] += bflo(x[i][c]); s[2 * c + 1] += bfhi(x[i][c]); }
#pragma unroll
    for (int r = 0; r < 4; ++r) {
        const int cnt = (t0 + r + 1) < W ? (t0 + r + 1) : W; const float rc = 1.0f / (float)cnt;
        const u32x4 cur = x[W - 1 + r]; u32x4 o;
#pragma unroll
        for (int c = 0; c < 4; ++c) o[c] = cvtpk(s[2 * c] * rc - bflo(cur[c]), s[2 * c + 1] * rc - bfhi(cur[c]));
        st16(op + (size_t)r * 1024, o);
        if (r < 3) {
#pragma unroll
            for (int c = 0; c < 4; ++c) { s[2 * c] += bflo(x[W + r][c]) - bflo(x[r][c]); s[2 * c + 1] += bfhi(x[W + r][c]) - bfhi(x[r][c]); } }
    }
}
__device__ __forceinline__ void pool_unit(int b, int g, int xb, const bf16* Z, bf16* A2, int tid) {
    if (g == 0) pool_unit_w<2>(b, g, xb, Z, A2, tid); else if (g == 1) pool_unit_w<4>(b, g, xb, Z, A2, tid); else if (g == 2) pool_unit_w<8>(b, g, xb, Z, A2, tid); else pool_unit_w<16>(b, g, xb, Z, A2, tid);
}

__device__ __forceinline__ void moe_weight_items(Frame& F) {
    LAS float* scr = (LAS float*)(F.lds + RING_OFF + F.wave * 16384);
    const int gw = F.vcu * NWAVES + F.wave, NGW = F.G * NWAVES, lane = F.lane; unsigned char* ws = F.ws;
    for (int it0 = gw; it0 < 6144; it0 += 3 * NGW) {
        float v[3][32]; const float* W[3]; int ldw[3], k0[3], n0[3], ldt[3], drow[3]; bf16* WT[3]; const float* gain[3]; unsigned char* WT8[3];
#pragma unroll
        for (int j = 0; j < 3; ++j) { int r = it0 + j * NGW; if (r >= 6144) r = it0;
            if (r < 4096) { const int up = r >= 2048; if (up) r -= 2048; const int e = r >> 7, kb = (r >> 3) & 15, nb = r & 7; n0[j] = nb * 32; k0[j] = kb * 64;
                W[j] = F.in[up ? I_WU : I_WG] + (size_t)e * 1024 * 256; ldw[j] = 256; WT[j] = nullptr; ldt[j] = 1024; drow[j] = e * 512 + (n0[j] >> 7) * 256 + up * 128 + (n0[j] & 127); gain[j] = F.in[I_FNORM]; WT8[j] = ws + WS_WGUT8; }
            else { r -= 4096; const int e = r >> 7, kb = (r >> 5) & 3, nb = r & 31; n0[j] = nb * 32; k0[j] = kb * 64;
                W[j] = F.in[I_WD] + (size_t)e * 256 * 1024; ldw[j] = 1024; WT[j] = nullptr; ldt[j] = 256; drow[j] = n0[j]; gain[j] = nullptr; WT8[j] = ws + WS_WDT + (size_t)e * 1024 * 256; }
            p0_transpose_load(v[j], W[j], ldw[j], k0[j], n0[j], lane); }
#pragma unroll
        for (int j = 0; j < 3; ++j) if (it0 + j * NGW < 6144) p0_transpose_store(v[j], k0[j], WT[j], ldt[j], drow[j], k0[j], gain[j], scr, lane, WT8[j], 32.0f);
    }
}

__device__ __forceinline__ void p2_attention(Frame& F) {
    unsigned char* ws = F.ws; const bf16* Z = (const bf16*)(ws + WS_RB); bf16* A2 = (bf16*)(ws + WS_RA); const unsigned char* KT = ws + WS_RD;
    float lam; { const int l = F.lane; const float s1 = wave_sum(F.in[I_LQ1][l] * F.in[I_LK1][l]), s2 = wave_sum(F.in[I_LQ2][l] * F.in[I_LK2][l]); lam = __expf(s1) - __expf(s2) + 0.2f; }
    for (int p = F.vcu; p < 256; p += F.G) { const int bh = p >> 5, b = bh >> 2, h = bh & 3, s = p & 31;
#ifdef PROBE_ATT
        for (int j = 0; j < 4; ++j) { const int xb = (j & 1) ? s : 63 - s;
#else
        for (int j = 0; j < 2; ++j) { const int xb = j ? s : 63 - s;
#endif
            pool_unit(b, h, xb, Z, A2, F.tid);
#ifdef PROBE_POOL
            pool_unit(b, h, xb, Z, A2, F.tid);
#endif
#ifdef PROBE_ATTMODE
            dat::attn_unit<8, PROBE_ATTMODE>(b, h, xb, Z, KT, (bf16*)(F.ws + WS_RC), F.in[I_RELB], F.in[I_SUBLN], lam, (LAS char*)(F.lds + RING_OFF));
#endif
            dat::attn_unit<8>(b, h, xb, Z, KT, A2, F.in[I_RELB], F.in[I_SUBLN], lam, (LAS char*)(F.lds + RING_OFF));
            } }
    struct FoldJobs { const bf16* KVc; unsigned char* ws; int vcu, G;
        __device__ __forceinline__ TileJob operator()(int i) const { const int tI = vcu + i * G, t2 = tI & 511, bh = t2 >> 6, b = bh >> 2, hh = bh & 3, w = t2 & 63; TileJob j;
            if (tI < 512) { const int kt = w >> 4, kkt = w & 15;
                j.A = KVc + (size_t)(b * 256 + kt * 64) * 2048 + hh * 256; j.lda = 2048; j.B = (const bf16*)(ws + WS_WQN) + (size_t)(kkt * 64) * 1024 + hh * 256; j.ldb = 1024;
                j.C = (bf16*)(ws + WS_BTS + (size_t)b * 1024 * 1024 + (size_t)(hh * 256 + kt * 64) * 1024 + kkt * 64); j.ldc = 1024; j.c8 = 1; }
            else { const int nt = w >> 2, kt = w & 3;
                j.A = (const bf16*)(ws + WS_WOT) + (size_t)(nt * 64) * 1024 + hh * 256; j.lda = 1024; j.B = KVc + (size_t)(b * 256 + kt * 64) * 2048 + 1024 + hh * 256; j.ldb = 2048;
                j.C = (bf16*)(ws + WS_BTO + (size_t)b * 1024 * 1024 + (size_t)(nt * 64) * 1024 + hh * 256 + kt * 64); j.ldc = 1024; j.c8 = 1; }
            return j; } };
    const PlainJobs<FoldJobs> fj{FoldJobs{(const bf16*)(ws + WS_KVC), ws, F.vcu, F.G}};
    tile_pipe<128, 2>((LAS char*)(F.lds + RING_OFF), (1024 - F.vcu + F.G - 1) / F.G, fj, F.wave, F.lane);
}

struct RouteJobs { const bf16* H2; const bf16* WR; LAS float* lg; int chunk;
    __device__ __forceinline__ const bf16* arow(int, int row) const { return H2 + (size_t)(chunk * 64 + row) * 1024; }
    __device__ __forceinline__ const bf16* brow(int, int row) const { return WR + (size_t)(row & 31) * 1024; }
    __device__ __forceinline__ void store(int, int wave, int lane, f32x4 acc0, f32x4 acc1) const {
        if ((wave >> 2) == 0) { LAS float* p = lg + (16 * (wave & 3) + (lane & 15)) * 33 + 4 * (lane >> 4);
#pragma unroll
            for (int j = 0; j < 4; ++j) { p[j] = acc0[j]; p[16 + j] = acc1[j]; } } }
};
__device__ __forceinline__ void p6_route(Frame& F) {
    unsigned char* ws = F.ws; const float* SSQ2 = (const float*)(ws + WS_SSQ2);
    LAS int* lcnt = (LAS int*)(F.lds + LTAB_OFF); LAS int* gbase = lcnt + 16; LAS float* lg = (LAS float*)(F.lds + LTAB_OFF + 1024);
    if (F.tid < 16) lcnt[F.tid] = 0;
    for (int chunk = F.vcu; chunk < M / 64; chunk += F.G) {
        const RouteJobs rj{(const bf16*)(ws + WS_H2B), (const bf16*)(ws + WS_WR), lg, chunk};
        tile_pipe<128, 8>((LAS char*)(F.lds + RING_OFF), 1, rj, F.wave, F.lane);
        bool emit = false; int e0 = 0, e1 = 0, p0 = 0, p1 = 0; const int tok = chunk * 64 + F.tid; float w0 = 0.f, w1 = 0.f, rs = 0.f;
        if (F.tid < 64) {
            { const f32x4* sp = (const f32x4*)(SSQ2 + (size_t)tok * 16); const f32x4 st = (sp[0] + sp[1]) + (sp[2] + sp[3]); rs = 1.0f / __builtin_sqrtf(((st[0] + st[1]) + (st[2] + st[3])) * (1.0f / 1024.0f) + EPS); }
            const LAS float* l = lg + F.tid * 33;
            float gl[4];
#pragma unroll
            for (int j = 0; j < 4; ++j) gl[j] = l[16 + j] * rs + F.in[I_RGB][j];
            int gs = 0; float gm = gl[0];
#pragma unroll
            for (int j = 1; j < 4; ++j) if (gl[j] > gm) { gm = gl[j]; gs = j; }
            float den = 0.f;
#pragma unroll
            for (int j = 0; j < 4; ++j) den += __expf(gl[j] - gm);
            const float gwt = 1.0f / den;
            float el[4];
#pragma unroll
            for (int j = 0; j < 4; ++j) el[j] = l[gs * 4 + j] * rs + F.in[I_REB][gs * 4 + j];
            int i0 = 0; float v0 = el[0];
#pragma unroll
            for (int j = 1; j < 4; ++j) if (el[j] > v0) { v0 = el[j]; i0 = j; }
            int i1 = -1; float v1 = -3.0e38f;
#pragma unroll
            for (int j = 0; j < 4; ++j) if (j != i0 && el[j] > v1) { v1 = el[j]; i1 = j; }
            const float t0 = 1.0f / (1.0f + __expf(v1 - v0));
            emit = true; e0 = gs * 4 + i0; e1 = gs * 4 + i1; w0 = gwt * t0; w1 = gwt * (1.0f - t0);
            p0 = atomicAdd((int*)(lcnt + e0), 1); p1 = atomicAdd((int*)(lcnt + e1), 1);
        }
        __syncthreads();
        if (F.tid < 16) gbase[F.tid] = (int)__hip_atomic_fetch_add(F.ctl + CW_CNT + 64 * F.tid, (unsigned)lcnt[F.tid], RLX_AGENT);
        __syncthreads();
        if (emit) { int* LIST = (int*)(ws + WS_LIST); float* LR = (float*)(ws + WS_LISTR); float* LW = (float*)(ws + WS_LISTW);
            const int i0 = e0 * 16384 + gbase[e0] + p0, i1 = e1 * 16384 + gbase[e1] + p1;
            LIST[i0] = tok * 2; LR[i0] = rs; LW[i0] = w0; LIST[i1] = tok * 2 + 1; LR[i1] = rs; LW[i1] = w1; }
        __syncthreads();
        if (F.tid < 16) lcnt[F.tid] = 0;
    }
}

__device__ __forceinline__ int moe_table(Frame& F) {
    LAS int* tab = (LAS int*)(F.lds + LTAB_OFF);
    __syncthreads();
    if (F.tid < 16) tab[32 + F.tid] = (int)__hip_atomic_load(F.ctl + CW_CNT + 64 * F.tid, RLX_AGENT);
    __syncthreads();
    if (F.tid == 0) { int p = 0, pf = 0, pt = 0; for (int e = 0; e < 16; ++e) { const int n = tab[32 + e]; tab[e] = p; tab[64 + e] = pf; tab[96 + e] = pt; p += (n + 255) >> 8; pf += n >> 8; pt += ((n & 255) + 63) >> 6; } tab[16] = p; tab[80] = pf; tab[112] = pt; }
    __syncthreads();
    return __builtin_amdgcn_readfirstlane(tab[80]);
}
constexpr int TAIL_R = 4;
struct TailBase { LAS const int* tab; int off, V, CT, kid, nid;
    __device__ __forceinline__ int count(int ntt) const {
        if (kid < 0) return ntt > off ? (ntt - off + V - 1) / V : 0;
        const int rem = ntt % V; int c = rem > kid ? (rem - kid + nid - 1) / nid : 0; c = c > TAIL_R ? TAIL_R : c; return (ntt / V) * TAIL_R + c; }
    __device__ __forceinline__ void decode(int i, int& e, int& r0, int& nv, int& ct) const {
        const int J = kid < 0 ? off + i * V : (i / TAIL_R) * V + (i % TAIL_R) * nid + kid, trow = J / CT; ct = J % CT; int ee = 0;
#pragma unroll
        for (int j = 1; j < 16; ++j) ee += (trow >= tab[96 + j]) ? 1 : 0;
        ee = __builtin_amdgcn_readfirstlane(ee); e = ee;
        const int n = __builtin_amdgcn_readfirstlane(tab[32 + ee]), ptt = __builtin_amdgcn_readfirstlane(tab[96 + ee]);
        r0 = (n >> 8) * 256 + (trow - ptt) * 64; nv = n - r0 < 64 ? n - r0 : 64;
    }
};
__device__ __forceinline__ TailBase tail_base(LAS const int* tab, int vcu, int G, int CT, int nidle) {
    const int nb = G - nidle; TailBase t; t.tab = tab; t.CT = CT; t.nid = nidle; t.V = nb + TAIL_R * nidle;
    if (vcu >= nb) { t.kid = vcu - nb; t.off = 0; } else { t.kid = -1; t.off = TAIL_R * nidle + vcu; }
    return t; }
struct TailGateUp { TailBase tb; const bf16* H2b; const bf16* WguT; const int* list; const float* listr; const float* listw; unsigned char* ACT; float ascale; bool wt;
    __device__ __forceinline__ const bf16* arow(int i, int lane) const { int e, r0, nv, ct; tb.decode(i, e, r0, nv, ct); const int tok = lane < nv ? (list[e * 16384 + r0 + lane] >> 1) : 0; return H2b + (size_t)tok * 512; }
    __device__ __forceinline__ const bf16* brow(int i, int lane) const { int e, r0, nv, ct; tb.decode(i, e, r0, nv, ct); const int c = ct * 32 + (lane >> 5) * 16 + (lane & 15), up = (lane >> 4) & 1;
        return WguT + (size_t)(e * 512 + (c >> 7) * 256 + up * 128 + (c & 127)) * 512; }
    __device__ __forceinline__ void store(int i, int wave, int lane, f32x4 acc0, f32x4 acc1) const { int e, r0, nv, ct; tb.decode(i, e, r0, nv, ct);
        const int row = 16 * (wave & 3) + (lane & 15); const bool ok = row < nv; const int li = e * 16384 + r0 + row;
        const float rs = ok ? listr[li] * ascale : 0.f, cw = ok ? listw[li] * 8.0f : 0.f; float a[4];
#pragma unroll
        for (int j = 0; j < 4; ++j) { const float g = acc0[j] * rs, up = acc1[j] * rs; a[j] = __builtin_amdgcn_fmed3f(g * __builtin_amdgcn_rcpf(1.0f + __builtin_amdgcn_exp2f(-g * LOG2E)) * up * cw, -448.0f, 448.0f); }
        unsigned* dp = (unsigned*)(ACT + (size_t)(tb.tab[e] * 256 + r0 + row) * 256 + ct * 32 + (wave >> 2) * 16 + 4 * (lane >> 4)); const unsigned dv = pk4_fp8(a[0], a[1], a[2], a[3]);
        if (wt) __hip_atomic_store(dp, dv, RLX_AGENT); else *(GAS unsigned*)dp = dv; }
};
struct TailDown { TailBase tb; const bf16* ACT; const bf16* WdT; const int* list; unsigned char* YS; float ascale;
    __device__ __forceinline__ const bf16* arow(int i, int lane) const { int e, r0, nv, ct; tb.decode(i, e, r0, nv, ct); return ACT + (size_t)(tb.tab[e] * 256 + r0 + lane) * 128; }
    __device__ __forceinline__ const bf16* brow(int i, int lane) const { int e, r0, nv, ct; tb.decode(i, e, r0, nv, ct); return WdT + (size_t)e * 1024 * 128 + (size_t)(ct * 64 + lane) * 128; }
    __device__ __forceinline__ void store(int i, int wave, int lane, f32x4 acc0, f32x4 acc1) const { int e, r0, nv, ct; tb.decode(i, e, r0, nv, ct);
        const int row = 16 * (wave & 3) + (lane & 15);
        if (row < nv) { const unsigned v = (unsigned)list[e * 16384 + r0 + row]; unsigned char* cp = YS + ((size_t)(((v & 1u) << 14) + (v >> 1)) << 10) + ct * 64 + 32 * (wave >> 2) + 4 * (lane >> 4);
            acc0 *= ascale; acc1 *= ascale;
            *(GAS unsigned*)cp = pk4_fp8(__builtin_amdgcn_fmed3f(acc0[0], -448.f, 448.f), __builtin_amdgcn_fmed3f(acc0[1], -448.f, 448.f), __builtin_amdgcn_fmed3f(acc0[2], -448.f, 448.f), __builtin_amdgcn_fmed3f(acc0[3], -448.f, 448.f));
            *(GAS unsigned*)(cp + 16) = pk4_fp8(__builtin_amdgcn_fmed3f(acc1[0], -448.f, 448.f), __builtin_amdgcn_fmed3f(acc1[1], -448.f, 448.f), __builtin_amdgcn_fmed3f(acc1[2], -448.f, 448.f), __builtin_amdgcn_fmed3f(acc1[3], -448.f, 448.f)); } }
};

__device__ __forceinline__ void p9_final(Frame& F) {
    const int gw = F.vcu * NWAVES + F.wave, NGW = F.G * NWAVES, lane = F.lane; const unsigned char* YS = F.ws + WS_RB; const bf16* H2 = (const bf16*)(F.ws + WS_H2B);
    const GAS f32x4* gr = (const GAS f32x4*)F.in[I_FINAL] + lane;
    for (int m0 = 2 * gw; m0 < M; m0 += 2 * NGW) {
        f32x4 v[2][4]; u32x2 hb[2][4]; unsigned a[2][4], c[2][4]; float s[2];
#pragma unroll
        for (int r = 0; r < 2; ++r) { const int m = m0 + r; const GAS u32x2* xr = (const GAS u32x2*)(H2 + (size_t)m * D) + lane;
            const GAS unsigned* y0 = (const GAS unsigned*)(YS + (size_t)m * D) + lane; const GAS unsigned* y1 = (const GAS unsigned*)(YS + ((size_t)M + m) * D) + lane;
#pragma unroll
            for (int j = 0; j < 4; ++j) { hb[r][j] = xr[64 * j]; a[r][j] = y0[64 * j]; c[r][j] = y1[64 * j]; } }
#pragma unroll
        for (int r = 0; r < 2; ++r) { s[r] = 0.f;
#pragma unroll
            for (int j = 0; j < 4; ++j) { const auto a01 = __builtin_amdgcn_cvt_pk_f32_fp8((int)a[r][j], false), a23 = __builtin_amdgcn_cvt_pk_f32_fp8((int)a[r][j], true), c01 = __builtin_amdgcn_cvt_pk_f32_fp8((int)c[r][j], false), c23 = __builtin_amdgcn_cvt_pk_f32_fp8((int)c[r][j], true);
                v[r][j].x = bflo(hb[r][j].x) + (a01[0] + c01[0]) * 0.0625f; v[r][j].y = bfhi(hb[r][j].x) + (a01[1] + c01[1]) * 0.0625f;
                v[r][j].z = bflo(hb[r][j].y) + (a23[0] + c23[0]) * 0.0625f; v[r][j].w = bfhi(hb[r][j].y) + (a23[1] + c23[1]) * 0.0625f;
                s[r] += (v[r][j].x * v[r][j].x + v[r][j].y * v[r][j].y) + (v[r][j].z * v[r][j].z + v[r][j].w * v[r][j].w); } }
#pragma unroll
        for (int r = 0; r < 2; ++r) { const float rstd = 1.f / __builtin_sqrtf(wave_sum(s[r]) * (1.f / D) + EPS); GAS f32x4* xo = (GAS f32x4*)(F.out + (size_t)(m0 + r) * D) + lane;
#pragma unroll
            for (int j = 0; j < 4; ++j) { const f32x4 g = gr[64 * j]; __builtin_nontemporal_store(v[r][j] * rstd * g, xo + 64 * j); } }
    }
}
struct Args { const float* in[27]; float* out; unsigned char* ws; int ph_lo, ph_hi, li, pad; };
__global__ void __launch_bounds__(NWAVES * 64, 2) hybrid_fwd(Args args) {
    extern __shared__ __attribute__((aligned(16))) unsigned char lds[];
    Frame F;
    F.lds = (LAS unsigned char*)lds;
    F.MISC = (volatile LAS unsigned*)(F.lds + MISC_OFF);
    F.tid = threadIdx.x; F.lane = F.tid & 63; F.wave = __builtin_amdgcn_readfirstlane(F.tid >> 6);
    F.G = gridDim.x; { const int bx = blockIdx.x; F.vcu = (F.G % 8 == 0) ? (bx % 8) * (F.G / 8) + bx / 8 : bx; }
    unsigned char* ws = args.ws; F.ws = ws; F.out = args.out;
#pragma unroll
    for (int i = 0; i < 27; ++i) F.in[i] = args.in[i];
    F.ctl = (gu32*)(ws + WS_CTL);
    for (int u = F.tid; u < (LDS_BYTES - LDSCTL_OFF) / 4; u += NWAVES * 64) ((LAS unsigned*)(F.lds + LDSCTL_OFF))[u] = 0u;
    __syncthreads();
    XcdBarrier bar = xcd_barrier_post((unsigned*)(F.ctl + CW_BAR) + args.li * XCD_BAR_WORDS, F.MISC + 8);
    if (threadIdx.x == 0) __hip_atomic_store((unsigned*)(F.ctl + CW_XCC) + F.vcu, 1u + bar.x, RLX_AGENT);
    const int lo = args.ph_lo, hi = args.ph_hi;
#ifndef PH_MASK
#define PH_MASK 0x3ff
#endif
#define IN(k) ((((PH_MASK) >> (k)) & 1) && lo <= (k) && (k) < hi)
#define BOTH(k) (IN(k) && IN((k) + 1))
#ifndef PROBE_MASK
#define PROBE_MASK 0
#endif
#define REP(k) (((PROBE_MASK) >> (k)) & 1)
#define GRID_BAR() xcd_barrier(bar)

    if (IN(0)) { p0_prologue<1>(F); if (REP(0)) { p0_prologue<2>(F); GRID_BAR(); p0_prologue<3>(F); }
        if (BOTH(0)) { const unsigned g0 = xcd_barrier_arrive(bar); p0_prologue<2>(F); xcd_barrier_wait(bar, g0); } else p0_prologue<2>(F); }

    if (IN(1)) {
        {
            struct KvJobs { unsigned char* ws; int vcu, G;
                __device__ __forceinline__ TileJob operator()(int i) const { const int tI = vcu + i * G, rt = tI >> 5, ct = tI & 31; TileJob j;
                    j.A = (const bf16*)(ws + WS_MN) + (size_t)(rt * 64) * 1024; j.lda = 1024; j.B = (const bf16*)(ws + WS_WKVT) + (size_t)(ct * 64) * 1024; j.ldb = 1024;
                    j.C = (bf16*)(ws + WS_KVC) + (size_t)(rt * 64) * 2048 + ct * 64; j.ldc = 2048; j.c8 = 0; return j; } };
            const PlainJobs<KvJobs> kj{KvJobs{ws, F.vcu, F.G}};
            tile_pipe<128, 8>((LAS char*)(F.lds + RING_OFF), (256 - F.vcu + F.G - 1) / F.G, kj, F.wave, F.lane);
        }
        pg8::DenseOrder S; S.init(ws + WS_XB, ws + WS_WINT, M, 2048, D, 0, F.G, (int)blockIdx.x);
        pg8::EpiZ E{(bf16*)(ws + WS_RB), ws + WS_RD, C2, (const float*)(ws + WS_RSX), F.lds + 131072};
        pg8::gemm_phase<pg8::EpiZ, pg8::DenseOrder, true>(F.lds + RING_OFF, D, S, E); if (REP(1)) { GRID_BAR(); pg8::gemm_phase<pg8::EpiZ, pg8::DenseOrder, true>(F.lds + RING_OFF, D, S, E); }
        unsigned g1 = 0u; if (BOTH(1)) g1 = xcd_barrier_arrive(bar);
        {
            struct PfJobs { unsigned char* ws; int vcu, G;
                __device__ __forceinline__ TileJob operator()(int i) const { const int tI = vcu + i * G, g = tI >> 5, nt = (tI >> 1) & 15, ct = tI & 1; TileJob j;
                    j.A = (const bf16*)(ws + WS_WTMP) + (size_t)(nt * 64) * 512 + g * 128; j.lda = 512; j.B = (const bf16*)(ws + WS_PWS) + (size_t)(g * 128 + ct * 64) * 128; j.ldb = 128;
                    j.C = (bf16*)(ws + WS_WOUTT) + (size_t)(nt * 64) * 1024 + 512 + g * 128 + ct * 64; j.ldc = 1024; j.c8 = 0; return j; } };
            const PlainJobs<PfJobs> pj{PfJobs{ws, F.vcu, F.G}};
            tile_pipe<128, 1>((LAS char*)(F.lds + RING_OFF), F.vcu < 128 ? (128 - F.vcu + F.G - 1) / F.G : 0, pj, F.wave, F.lane);
        }
        if (BOTH(1)) xcd_barrier_wait(bar, g1);
    }

    if (IN(2)) { p2_attention(F);
        if (REP(2)) { GRID_BAR(); p2_attention(F); }
        if (BOTH(2)) { const unsigned g2 = xcd_barrier_arrive(bar); moe_weight_items(F); xcd_barrier_wait(bar, g2); } else moe_weight_items(F); }

    const bool panel = (PROBE_MASK) == 0 && F.G == 256 && BOTH(3) && BOTH(4) && BOTH(5);
    unsigned* const pcnt = (unsigned*)(F.ctl + CW_PAN); unsigned* const ptmo = (unsigned*)(F.ctl + CW_BAR) + args.li * XCD_BAR_WORDS + XB_TMO;
    int mypm = 0; bool plocal = false, rlocal = false;
    if (panel) { pg8::DenseOrder S0; S0.init(ws, ws, M, D, D, 0, F.G, (int)blockIdx.x); pg8::Unit u0; S0.next(0, u0); mypm = u0.pm;
        unsigned same = 1u; const unsigned me = 1u + bar.x;
#pragma unroll
        for (int j = 0; j < 4; ++j) { same &= (xb_ld((unsigned*)(F.ctl + CW_XCC) + 32 * (mypm >> 3) + 8 * j + (mypm & 7)) == me) ? 1u : 0u; same &= (xb_ld((unsigned*)(F.ctl + CW_XCC) + 4 * mypm + j) == me) ? 1u : 0u; }
        plocal = __builtin_amdgcn_readfirstlane((int)same) != 0;
        unsigned rs = 1u; const int rp = F.vcu >> 2;
#pragma unroll
        for (int j = 0; j < 4; ++j) rs &= (xb_ld((unsigned*)(F.ctl + CW_XCC) + 32 * (rp >> 3) + 8 * j + (rp & 7)) == me) ? 1u : 0u;
        rlocal = __builtin_amdgcn_readfirstlane((int)rs) != 0; }

    if (IN(3)) {
        pg8::DenseOrder S; S.init(ws + WS_RA, ws + WS_WOUTT, M, D, D, 0, F.G, (int)blockIdx.x);
        pg8::EpiRes<true, true> E{(const bf16*)(ws + WS_XB), (bf16*)(ws + WS_RC), (float*)(ws + WS_SSQ1), ws + WS_RD + 16 * MiB, 1.0f};
        pg8::gemm_phase<pg8::EpiRes<true, true>, pg8::DenseOrder, true>(F.lds + RING_OFF, D, S, E); if (REP(3)) { GRID_BAR(); pg8::gemm_phase<pg8::EpiRes<true, true>, pg8::DenseOrder, true>(F.lds + RING_OFF, D, S, E); }
        if (panel) { panel_signal(pcnt + (0 * 64 + mypm) * 16, plocal); panel_wait(pcnt + (0 * 64 + mypm) * 16, 4u, ptmo, !plocal); }
    }

    if (IN(4)) {
        pg8::DenseOrder S; S.init(ws + WS_RD + 16 * MiB, ws + WS_BTS, M, D, D / 2, (size_t)1024 * 1024, F.G, (int)blockIdx.x);
        pg8::EpiSoftmax E{(const float*)(ws + WS_SSQ1), ws + WS_RD};
        pg8::gemm_phase<pg8::EpiSoftmax, pg8::DenseOrder, false, true>(F.lds + RING_OFF, D / 2, S, E); if (REP(4)) { GRID_BAR(); pg8::gemm_phase<pg8::EpiSoftmax, pg8::DenseOrder, false, true>(F.lds + RING_OFF, D / 2, S, E); }
        if (panel) { panel_signal(pcnt + (1 * 64 + mypm) * 16, plocal); panel_wait(pcnt + (1 * 64 + mypm) * 16, 4u, ptmo, !plocal); }
    }

    if (IN(5)) {
        pg8::DenseOrder S; S.init(ws + WS_RD, ws + WS_BTO, M, D, D / 2, (size_t)1024 * 1024, F.G, (int)blockIdx.x);
        pg8::EpiRes<true, true> E{(const bf16*)(ws + WS_RC), (bf16*)(ws + WS_H2B), (float*)(ws + WS_SSQ2), ws + WS_RD + 16 * MiB, 1.0f / 256.0f};
        pg8::gemm_phase<pg8::EpiRes<true, true>, pg8::DenseOrder, true, true>(F.lds + RING_OFF, D / 2, S, E); if (REP(5)) { GRID_BAR(); pg8::gemm_phase<pg8::EpiRes<true, true>, pg8::DenseOrder, true, true>(F.lds + RING_OFF, D / 2, S, E); }
        if (panel) { panel_signal(pcnt + (2 * 64 + mypm) * 16, plocal); panel_wait(pcnt + (2 * 64 + (F.vcu >> 2)) * 16, 4u, ptmo, !rlocal); }
    }

    if (IN(6)) { p6_route(F); if (BOTH(6)) GRID_BAR(); }

    const bool fusedmoe = (PROBE_MASK) == 0 && F.G == 256 && BOTH(7); unsigned gT = 0u;
    if (IN(7)) {
        const int nft = moe_table(F); LAS const int* tab = (LAS const int*)(F.lds + LTAB_OFF);
        { const int ntt = __builtin_amdgcn_readfirstlane(tab[112]) * 8;
          const TailBase tb = tail_base(tab, F.vcu, F.G, 8, fusedmoe ? F.G - 2 * nft : 0);
          const TailGateUp tj{tb, (const bf16*)(ws + WS_RD + 16 * MiB), (const bf16*)(ws + WS_WGUT8), (const int*)(ws + WS_LIST), (const float*)(ws + WS_LISTR), (const float*)(ws + WS_LISTW), ws + WS_RC, 1.0f / 32.0f, fusedmoe};
          tile_pipe<128, 4, true>((LAS char*)(F.lds + RING_OFF), tb.count(ntt), tj, F.wave, F.lane); }
        if (fusedmoe) gT = xcd_barrier_arrive(bar, false);
        pg8::MoeOrder<2, true> S{tab, (const char*)(ws + WS_RD + 16 * MiB), (const char*)(ws + WS_WGUT8), (const int*)(ws + WS_LIST), F.G, F.vcu, nft * 2, (size_t)512 * 1024, (size_t)256 * 1024};
        pg8::EpiGateUp E{ws + WS_RC, (const float*)(ws + WS_LISTR), (const float*)(ws + WS_LISTW), 1.0f / 32.0f};
        pg8::gemm_phase<pg8::EpiGateUp, pg8::MoeOrder<2, true>, true, true>(F.lds + RING_OFF, D / 2, S, E);
        if (REP(7)) { GRID_BAR(); pg8::gemm_phase<pg8::EpiGateUp, pg8::MoeOrder<2, true>, true, true>(F.lds + RING_OFF, D / 2, S, E); }
        if (REP(10)) { GRID_BAR(); const int ntt = __builtin_amdgcn_readfirstlane(tab[112]) * 8;
          const TailBase tb = tail_base(tab, F.vcu, F.G, 8, 0);
          const TailGateUp tj{tb, (const bf16*)(ws + WS_RD + 16 * MiB), (const bf16*)(ws + WS_WGUT8), (const int*)(ws + WS_LIST), (const float*)(ws + WS_LISTR), (const float*)(ws + WS_LISTW), ws + WS_RC, 1.0f / 32.0f, false};
          tile_pipe<128, 4, true>((LAS char*)(F.lds + RING_OFF), tb.count(ntt), tj, F.wave, F.lane); }
        if (BOTH(7) && !fusedmoe) GRID_BAR();
    }

    if (IN(8)) {
        LAS const int* tab = (LAS const int*)(F.lds + LTAB_OFF);
        const int nft = IN(7) ? __builtin_amdgcn_readfirstlane(tab[80]) : moe_table(F);
        if (fusedmoe && F.vcu < nft * 2) {
            unsigned* pc = (unsigned*)(F.ctl + CW_PAIR) + (F.vcu >> 1) * 16;
            const bool plc = xb_ld((unsigned*)(F.ctl + CW_XCC) + (F.vcu ^ 1)) == 1u + bar.x;
            panel_signal(pc, plc); panel_wait(pc, 2u, ptmo, !plc); }
        pg8::MoeOrder<4, false> S{tab, (const char*)(ws + WS_RC), (const char*)(ws + WS_WDT), (const int*)(ws + WS_LIST), F.G, F.vcu, nft * 4, (size_t)1024 * 256, (size_t)256 * 256, (size_t)FF, fusedmoe};
        pg8::EpiDown E{ws + WS_RB, (const int*)(ws + WS_LIST), 1.0f / 16.0f};
        pg8::gemm_phase<pg8::EpiDown, pg8::MoeOrder<4, false>, true, true>(F.lds + RING_OFF, FF / 2, S, E);
        if (REP(8)) { GRID_BAR(); pg8::gemm_phase<pg8::EpiDown, pg8::MoeOrder<4, false>, true, true>(F.lds + RING_OFF, FF / 2, S, E); }
        if (fusedmoe) xcd_barrier_wait(bar, gT);
        { const int ntt = __builtin_amdgcn_readfirstlane(tab[112]) * 16;
          const TailBase tb = tail_base(tab, F.vcu, F.G, 16, fusedmoe ? F.G - 2 * nft : 0);
          const TailDown tj{tb, (const bf16*)(ws + WS_RC), (const bf16*)(ws + WS_WDT), (const int*)(ws + WS_LIST), ws + WS_RB, 1.0f / 16.0f};
          tile_pipe<128, 1, true>((LAS char*)(F.lds + RING_OFF), tb.count(ntt), tj, F.wave, F.lane); }
        if (BOTH(8)) GRID_BAR();
    }

    if (IN(9)) { p9_final(F); if (REP(9)) { GRID_BAR(); p9_final(F); } }
#undef IN
#undef BOTH
#undef GRID_BAR
}

extern "C" void kernel_launch(void* const* d_in, const int* in_sizes, int n_in, void* d_out, int out_size, void* d_ws, size_t ws_size, hipStream_t stream) {
    static int grid = 0;
    if (grid == 0) {
        if (n_in != 27 || in_sizes[0] != M * D || out_size != M * D || ws_size < WS_END) { fprintf(stderr, "kernel_launch: unexpected problem shape (n_in %d, in0 %d, out %d, ws %zu); nothing launched\n", n_in, n_in > 0 ? in_sizes[0] : -1, out_size, ws_size); grid = -1; return; }
        int dev = 0, cus = 0, per_cu = 0;
        if (hipGetDevice(&dev) != hipSuccess || hipDeviceGetAttribute(&cus, hipDeviceAttributeMultiprocessorCount, dev) != hipSuccess) { grid = -1; return; }
        if (hipFuncSetAttribute((const void*)hybrid_fwd, hipFuncAttributeMaxDynamicSharedMemorySize, LDS_BYTES) != hipSuccess) { fprintf(stderr, "kernel_launch: hipFuncSetAttribute failed\n"); grid = -1; return; }
        if (hipOccupancyMaxActiveBlocksPerMultiprocessor(&per_cu, (const void*)hybrid_fwd, NWAVES * 64, LDS_BYTES) != hipSuccess || per_cu < 1) { fprintf(stderr, "kernel_launch: occupancy query reports %d workgroups per CU\n", per_cu); }
        (void)hipGetLastError();
        grid = cus < 256 ? cus : 256;
        if (grid != 256) fprintf(stderr, "kernel_launch: %d CUs: the single-unit GEMM phases assume 256 workgroups\n", grid);
    }
    if (grid < 0) return;
    if (hipMemsetAsync((char*)d_ws + WS_CTL, 0, CTL_ZERO_BYTES, stream) != hipSuccess) return;
    Args a{};
    for (int i = 0; i < 27; ++i) a.in[i] = (const float*)d_in[i];
    a.out = (float*)d_out; a.ws = (unsigned char*)d_ws; a.pad = 0;
    constexpr int NL = MK_N_LAUNCHES;
    for (int li = 0; li < NL; ++li) {
        a.ph_lo = (NL == 1) ? 0 : li; a.ph_hi = (NL == 1) ? N_PHASES : li + 1; a.li = li;
        hipLaunchKernelGGL(hybrid_fwd, dim3(grid), dim3(NWAVES * 64), LDS_BYTES, stream, a);
    }
}
```
